# Optimizing an MI355X kernel written in HIP

```python
import math
import jax, jax.numpy as jnp
from jax import lax
import numpy as np

D_MODEL = 1024
BATCH = 2
SEQ = 8192
DEPTH = 4
DEC_BATCH = 32
DEC_SEQ = 8
PAST_LEN = 8192
PAGE_SIZE = 128

N_AB_LAYERS = (DEPTH + 1) // 2
N_C_LAYERS = DEPTH // 2
CHUNK = 128
W_A = D_MODEL // 2
G_A = 4
GA_CH = W_A // G_A
W_B = D_MODEL // 2
CONV_W = 3
WINDOWS = (128, 512, 2048)
DILATIONS = (1, 4, 16)
N_GROUPS = 3
H_G = 8
HEAD_DIM = 64
C_WIDTH = H_G * HEAD_DIM
QKV_COLS = N_GROUPS * C_WIDTH
D_FF = 4 * D_MODEL
ALPHA = (2.0 * DEPTH) ** 0.25
BETA = (8.0 * DEPTH) ** -0.25
LN_EPS = 1e-5
NEG_INF = -1e30

kernel_name = 'hybrid_gmlp_shortconv_dilated_attn_step'


def layer_norm(x, g, b):
    x32 = x.astype(jnp.float32)
    mu = jnp.mean(x32, -1, keepdims=True)
    var = jnp.mean(jnp.square(x32 - mu), -1, keepdims=True)
    y = (x32 - mu) * lax.rsqrt(var + LN_EPS)
    return (y * g.astype(jnp.float32) + b.astype(jnp.float32)).astype(x.dtype)


def alibi_slopes():
    return 2.0 ** (-(8.0 / H_G) * jnp.arange(1, H_G + 1, dtype=jnp.float32))


def chunk_spatial_mix(v, w_s, b_s):
    B, L, _ = v.shape
    nc = -(-L // CHUNK)
    Lp = nc * CHUNK
    vp = jnp.pad(v, ((0, 0), (0, Lp - L), (0, 0))).reshape(B, nc, CHUNK, G_A, GA_CH)
    causal = jnp.tril(jnp.ones((CHUNK, CHUNK), dtype=bool))
    w = jnp.where(causal[None], w_s, 0.0).astype(v.dtype)
    y = jnp.einsum('gij,bnjgc->bnigc', w, vp) + b_s.T.astype(v.dtype)[None, None, :, :, None]
    return y.reshape(B, Lp, W_A)[:, :L]


def causal_conv(buf, xin, w):
    L = xin.shape[1]
    xc = jnp.concatenate([buf, xin], axis=1)
    y = sum(xc[:, k:k + L] * w[k] for k in range(CONV_W))
    return y, xc[:, -(CONV_W - 1):]


def ab_mixer(x, conv_buf, w_in, ln_v_g, ln_v_b, w_s, b_s, conv_w, w_out):
    z = jnp.einsum('bld,de->ble', x, w_in)
    z_u, z_v, z_bg, z_cg, z_h = jnp.split(
        z, [W_A, 2 * W_A, 2 * W_A + W_B, 2 * W_A + 2 * W_B], axis=-1)
    u = jax.nn.gelu(z_u)
    v = layer_norm(jax.nn.gelu(z_v), ln_v_g, ln_v_b)
    a_out = u * chunk_spatial_mix(v, w_s, b_s)
    conv_out, new_buf = causal_conv(conv_buf, z_cg * z_h, conv_w)
    b_out = z_bg * conv_out
    out = jnp.einsum('ble,ed->bld', jnp.concatenate([a_out, b_out], axis=-1), w_out)
    return out, new_buf, v


def split_qkv(x, w_qkv):
    B, L, _ = x.shape
    qkv = jnp.einsum('bld,de->ble', x, w_qkv).reshape(B, L, 3, N_GROUPS, H_G, HEAD_DIM)
    return qkv[:, :, 0], qkv[:, :, 1], qkv[:, :, 2]


def dilated_group_prompt(q, k, v, d, n_back, slopes):
    B, S, H, dh = q.shape
    M = S // d
    nb = -(-M // CHUNK)
    Mp = nb * CHUNK

    def by_residue(a):
        a = a.reshape(B, M, d, H, dh).transpose(0, 2, 1, 3, 4)
        return jnp.pad(a, ((0, 0), (0, 0), (0, Mp - M), (0, 0), (0, 0)))

    def key_blocks(a):
        a = jnp.pad(by_residue(a), ((0, 0), (0, 0), (CHUNK, 0), (0, 0), (0, 0)))
        a = a.reshape(B, d, nb + 1, CHUNK, H, dh)
        return jnp.concatenate([a[:, :, :-1], a[:, :, 1:]], axis=3)

    qb = by_residue(q).reshape(B, d, nb, CHUNK, H, dh)
    kb, vb = key_blocks(k), key_blocks(v)
    logits = jnp.einsum('brnqhc,brnkhc->brnhqk', qb, kb).astype(jnp.float32) * (dh ** -0.5)
    qi = jnp.arange(CHUNK)[:, None]
    kj = jnp.arange(2 * CHUNK)[None, :]
    steps = CHUNK + qi - kj
    key_m = jnp.arange(nb)[:, None] * CHUNK + jnp.arange(2 * CHUNK)[None, :] - CHUNK
    valid = ((steps >= 0) & (steps <= n_back))[None] & (key_m >= 0)[:, None, :]
    bias = -slopes[:, None, None] * (steps * d).astype(jnp.float32)[None]
    logits = jnp.where(valid[:, None], logits + bias, NEG_INF)
    lse = jax.nn.logsumexp(logits, axis=-1)
    p = jnp.exp(logits - lse[..., None]).astype(v.dtype)
    o = jnp.einsum('brnhqk,brnkhc->brnqhc', p, vb)
    o = o.reshape(B, d, Mp, H, dh)[:, :, :M].transpose(0, 2, 1, 3, 4).reshape(B, S, H, dh)
    lse = lse.transpose(0, 1, 2, 4, 3).reshape(B, d, Mp, H)[:, :, :M]
    lse = lse.transpose(0, 2, 1, 3).reshape(B, S, H)
    return o, lse


def dilated_group_sample(q, k, v, k_buf, v_buf, d, n_back, slopes):
    T, dh = q.shape[1], q.shape[-1]
    L = k_buf.shape[1]
    kc = jnp.concatenate([k_buf, k], axis=1)
    vc = jnp.concatenate([v_buf, v], axis=1)
    steps = jnp.arange(n_back + 1)[None, :]
    idx = L + jnp.arange(T)[:, None] - steps * d
    valid = idx >= 0
    idx = jnp.maximum(idx, 0)
    kg = jnp.take(kc, idx, axis=1)
    vg = jnp.take(vc, idx, axis=1)
    logits = jnp.einsum('bthc,btkhc->bhtk', q, kg).astype(jnp.float32) * (dh ** -0.5)
    bias = -slopes[:, None, None] * (steps * d).astype(jnp.float32)[None]
    logits = jnp.where(valid[None, None], logits + bias, NEG_INF)
    lse = jax.nn.logsumexp(logits, axis=-1)
    p = jnp.exp(logits - lse[..., None]).astype(v.dtype)
    o = jnp.einsum('bhtk,btkhc->bthc', p, vg)
    return o, lse.transpose(0, 2, 1), kc[:, -L:], vc[:, -L:]


def merge_groups(outs, lses, w_out):
    alpha = jax.nn.softmax(jnp.stack(lses, axis=0), axis=0)
    o = sum(alpha[g][..., None].astype(outs[g].dtype) * outs[g] for g in range(N_GROUPS))
    B, L = o.shape[:2]
    return jnp.einsum('ble,ed->bld', o.reshape(B, L, C_WIDTH), w_out)


def c_mixer_prompt(x, w_qkv, w_out):
    q, k, v = split_qkv(x, w_qkv)
    slopes = alibi_slopes()
    S = x.shape[1]
    outs, lses, new_kv = [], [], []
    for g in range(N_GROUPS):
        d = DILATIONS[g]
        o, l = dilated_group_prompt(q[:, :, g], k[:, :, g], v[:, :, g], d, WINDOWS[g] // d, slopes)
        outs.append(o)
        lses.append(l)
        n_keep = min(WINDOWS[g], S)
        new_kv.append(jnp.stack([k[:, -n_keep:, g], v[:, -n_keep:, g]], axis=2))
    return merge_groups(outs, lses, w_out), new_kv


def c_mixer_sample(x, bufs, w_qkv, w_out):
    q, k, v = split_qkv(x, w_qkv)
    slopes = alibi_slopes()
    outs, lses, new_kv = [], [], []
    for g in range(N_GROUPS):
        d = DILATIONS[g]
        o, l, kb, vb = dilated_group_sample(q[:, :, g], k[:, :, g], v[:, :, g],
                                            bufs[g][:, :, 0], bufs[g][:, :, 1],
                                            d, WINDOWS[g] // d, slopes)
        outs.append(o)
        lses.append(l)
        new_kv.append(jnp.stack([kb, vb], axis=2))
    return merge_groups(outs, lses, w_out), new_kv


def sq_relu_mlp(x, w_up, w_down):
    h = jnp.square(jax.nn.relu(jnp.einsum('bld,df->blf', x, w_up)))
    return jnp.einsum('blf,fd->bld', h, w_down)


def setup_inputs(seed: int = 0) -> dict:
    key = jax.random.key(seed)
    ks = jax.random.split(key, 24)
    f32 = jnp.float32

    def nrm(k, shape, scale):
        return jax.random.normal(k, shape, f32) * scale

    win_lens = [min(w, PAST_LEN) for w in WINDOWS]
    col_scale = jnp.concatenate([jnp.ones((2 * QKV_COLS,), f32), jnp.full((QKV_COLS,), BETA, f32)])
    return {
        'x_prompt': nrm(ks[0], (BATCH, SEQ, D_MODEL), 1.0),
        'x_sample': nrm(ks[1], (DEC_BATCH, DEC_SEQ, D_MODEL), 1.0),
        'state_conv': nrm(ks[2], (N_AB_LAYERS, DEC_BATCH, CONV_W - 1, W_B), 1.0),
        'cache_kv_w128': nrm(ks[3], (N_C_LAYERS, DEC_BATCH, win_lens[0], 2, H_G, HEAD_DIM), 1.0),
        'cache_kv_w512': nrm(ks[4], (N_C_LAYERS, DEC_BATCH, win_lens[1], 2, H_G, HEAD_DIM), 1.0),
        'cache_kv_w2048': nrm(ks[5], (N_C_LAYERS, DEC_BATCH, win_lens[2], 2, H_G, HEAD_DIM), 1.0),
        'w_in_ab': nrm(ks[6], (N_AB_LAYERS, D_MODEL, 2 * W_A + 3 * W_B), D_MODEL ** -0.5),
        'ln_v_g': 1.0 + nrm(ks[7], (N_AB_LAYERS, W_A), 0.05),
        'ln_v_b': nrm(ks[8], (N_AB_LAYERS, W_A), 0.05),
        'w_spatial': nrm(ks[9], (N_AB_LAYERS, G_A, CHUNK, CHUNK), CHUNK ** -0.5),
        'b_spatial': 1.0 + nrm(ks[10], (N_AB_LAYERS, G_A, CHUNK), 0.1),
        'conv_w': nrm(ks[11], (N_AB_LAYERS, CONV_W, W_B), CONV_W ** -0.5),
        'w_out_ab': nrm(ks[12], (N_AB_LAYERS, W_A + W_B, D_MODEL), BETA * (W_A + W_B) ** -0.5),
        'w_qkv_c': nrm(ks[13], (N_C_LAYERS, D_MODEL, 3 * QKV_COLS), D_MODEL ** -0.5) * col_scale,
        'w_out_c': nrm(ks[14], (N_C_LAYERS, C_WIDTH, D_MODEL), BETA * C_WIDTH ** -0.5),
        'ln1_g': 1.0 + nrm(ks[15], (DEPTH, D_MODEL), 0.05),
        'ln1_b': nrm(ks[16], (DEPTH, D_MODEL), 0.05),
        'ln2_g': 1.0 + nrm(ks[17], (DEPTH, D_MODEL), 0.05),
        'ln2_b': nrm(ks[18], (DEPTH, D_MODEL), 0.05),
        'w_mlp_up': nrm(ks[19], (DEPTH, D_MODEL, D_FF), BETA * D_MODEL ** -0.5),
        'w_mlp_down': nrm(ks[20], (DEPTH, D_FF, D_MODEL), BETA * D_FF ** -0.5),
    }


def reference(x_prompt, x_sample, state_conv, cache_kv_w128, cache_kv_w512, cache_kv_w2048,
              w_in_ab, ln_v_g, ln_v_b, w_spatial, b_spatial, conv_w, w_out_ab,
              w_qkv_c, w_out_c, ln1_g, ln1_b, ln2_g, ln2_b, w_mlp_up, w_mlp_down):
    caches = (cache_kv_w128, cache_kv_w512, cache_kv_w2048)
    xp, xs = x_prompt, x_sample
    conv_p, conv_s, chunk_v_s = [], [], []
    kv_p = [[] for _ in range(N_GROUPS)]
    kv_s = [[] for _ in range(N_GROUPS)]
    for layer in range(DEPTH):
        i = layer // 2
        if layer % 2 == 0:
            params = (w_in_ab[i], ln_v_g[i], ln_v_b[i], w_spatial[i], b_spatial[i], conv_w[i], w_out_ab[i])
            zero_buf = jnp.zeros((xp.shape[0], CONV_W - 1, W_B), xp.dtype)
            mp, buf_p, _ = ab_mixer(xp, zero_buf, *params)
            ms, buf_s, v_s = ab_mixer(xs, state_conv[i], *params)
            conv_p.append(buf_p)
            conv_s.append(buf_s)
            chunk_v_s.append(v_s)
        else:
            mp, new_p = c_mixer_prompt(xp, w_qkv_c[i], w_out_c[i])
            ms, new_s = c_mixer_sample(xs, [c[i] for c in caches], w_qkv_c[i], w_out_c[i])
            for g in range(N_GROUPS):
                kv_p[g].append(new_p[g])
                kv_s[g].append(new_s[g])
        xp = layer_norm(ALPHA * xp + mp, ln1_g[layer], ln1_b[layer])
        xs = layer_norm(ALPHA * xs + ms, ln1_g[layer], ln1_b[layer])
        xp = layer_norm(ALPHA * xp + sq_relu_mlp(xp, w_mlp_up[layer], w_mlp_down[layer]), ln2_g[layer], ln2_b[layer])
        xs = layer_norm(ALPHA * xs + sq_relu_mlp(xs, w_mlp_up[layer], w_mlp_down[layer]), ln2_g[layer], ln2_b[layer])
    return (xp, xs,
            jnp.stack(conv_p), jnp.stack(conv_s), jnp.stack(chunk_v_s),
            jnp.stack(kv_p[0]), jnp.stack(kv_p[1]), jnp.stack(kv_p[2]),
            jnp.stack(kv_s[0]), jnp.stack(kv_s[1]), jnp.stack(kv_s[2]))
```

```cpp
#include <hip/hip_runtime.h>
#include <hip/hip_cooperative_groups.h>
#include <cstdio>
#include <cstdint>
namespace cg = cooperative_groups;
namespace pg8 {
#define PG8_LAS __attribute__((address_space(3)))
typedef unsigned short bf16_t;
typedef short bf16x8 __attribute__((ext_vector_type(8)));
typedef float f32x4 __attribute__((ext_vector_type(4)));
typedef unsigned u32x4 __attribute__((ext_vector_type(4)));
constexpr int BM = 256, BK = 64, HALF = 128, HTB = HALF * BK * 2  , STAGE_BYTES = 8 * HTB, NXCD = 8, WGM = 8;

__host__ __device__ __forceinline__ int lds_byte(int r, int c) { const int st = (r >> 4) * 2 + (c >> 5), rr = r & 15, cc = c & 31, ob = rr * 64 + cc * 2; return st * 1024 + (ob ^ (((ob >> 9) & 1) << 5)); }
__host__ __device__ __forceinline__ void stage_rc(int b, int& R, int& C) { const int st = b / 1024, sb = b % 1024, swz = sb ^ (((sb >> 9) & 1) << 5); R = (st >> 1) * 16 + swz / 64; C = (st & 1) * 32 + (swz % 64) / 2; }
__host__ __device__ __forceinline__ int perm32(int rho) { const int n = rho >> 4, i = rho & 15; return 8 * (i >> 2) + 4 * n + (i & 3); }

struct Unit { int pm, pn, k0, nt; };
struct Gemm { const bf16_t* A; const bf16_t* Bt; int M, N, K; };

struct StaticOrder {
    int nM, nN, nwg, G, c, KT;
    __host__ __device__ void init(int M, int N, int G_, int c_, int K_) { nM = M / BM; nN = N / BM; nwg = nM * nN; G = G_; c = c_; KT = K_ / BK; }
    __host__ __device__ bool next(int i, Unit& u) const {
        const long L = (long)i * G + c; if (L >= nwg) return false;
        int wgid = (int)L; { const int q = nwg / NXCD, r = nwg % NXCD, xcd = wgid % NXCD, off = wgid / NXCD; wgid = (xcd < r ? xcd * (q + 1) : r * (q + 1) + (xcd - r) * q) + off; }
        const int nig = WGM * nN, gid = wgid / nig, fm = gid * WGM, gsz = (nM - fm) < WGM ? (nM - fm) : WGM;
        u.pm = fm + ((wgid % nig) % gsz); u.pn = (wgid % nig) / gsz; u.k0 = 0; u.nt = KT; return true;
    }
    __device__ __forceinline__ void a_ready(const Unit&) const {}
    __device__ __forceinline__ void done(const Unit&) const {}
};
__device__ __forceinline__ unsigned cvt_pk_bf16(float lo, float hi) { unsigned r; asm volatile("v_cvt_pk_bf16_f32 %0, %1, %2" : "=v"(r) : "v"(lo), "v"(hi)); return r; }
template <class Epi, class Sched, bool ALIGN_EPI = false, bool SP2 = false>
__device__ __forceinline__ void gemm_phase(PG8_LAS unsigned char* lds, const Gemm g, const Sched& S, const Epi& E) {
    int tid_ = threadIdx.x; asm volatile("" : "+v"(tid_)); const int tid = tid_, wid = __builtin_amdgcn_readfirstlane(tid >> 6), lane = tid & 63, wr = wid >> 2, wc = wid & 3, fr = lane & 15, fq = lane >> 4;
    const int K = g.K;
    unsigned voffA[2], voffB[2];
#pragma unroll
    for (int i = 0; i < 2; ++i) { int R, C; stage_rc(tid * 16 + i * 8192, R, C); const int Rb = Epi::PERM ? ((R & ~31) + perm32(R & 31)) : R;
        voffA[i] = (unsigned)(R * K + C) * 2u; voffB[i] = (unsigned)(Rb * K + C) * 2u; }
    const size_t kstep = (size_t)(BK * 2);
    const size_t hstep = (size_t)HALF * K * 2;
    const size_t tstep = 2 * hstep;
    const unsigned ldsw = (unsigned)wid * 1024u;
    const int aoff = lds_byte(wr * 64 + fr, fq * 8), boff = lds_byte(wc * 32 + fr, fq * 8);
#define PG8_SA(b, h) (((b) * 2 + (h)) * HTB)
#define PG8_SB(b, h) ((4 + (b) * 2 + (h)) * HTB)
#define PG8_STAGE(bufoff, gbase, voff) do { _Pragma("unroll") for (int _i = 0; _i < 2; ++_i) \
        __builtin_amdgcn_global_load_lds((const unsigned*)((const char*)(gbase) + (voff)[_i]), (PG8_LAS unsigned*)(lds + (bufoff) + ldsw + _i * 8192), 16, 0, 0); } while (0)
#define PG8_LDA(dst, b, h) do { _Pragma("unroll") for (int m = 0; m < 4; ++m) _Pragma("unroll") for (int k = 0; k < 2; ++k) dst[m][k] = *(const PG8_LAS bf16x8*)(lds + PG8_SA(b, h) + aoff + m * 2048 + k * 1024); } while (0)
#define PG8_LDB(dst, b, h) do { _Pragma("unroll") for (int n = 0; n < 2; ++n) _Pragma("unroll") for (int k = 0; k < 2; ++k) dst[n][k] = *(const PG8_LAS bf16x8*)(lds + PG8_SB(b, h) + boff + n * 2048 + k * 1024); } while (0)
#define PG8_MMA(ai, bj, At, Bt) do { __builtin_amdgcn_s_setprio(1); _Pragma("unroll") for (int m = 0; m < 4; ++m) _Pragma("unroll") for (int n = 0; n < 2; ++n) _Pragma("unroll") for (int k = 0; k < 2; ++k) \
        acc[ai][bj][m][n] = __builtin_amdgcn_mfma_f32_16x16x32_bf16(Bt[n][k], At[m][k], acc[ai][bj][m][n], 0, 0, 0); __builtin_amdgcn_s_setprio(0); } while (0)
#define PG8_WAIT_V(n) asm volatile("s_waitcnt vmcnt(" #n ")" ::: "memory")
#define PG8_WAIT_L(n) asm volatile("s_waitcnt lgkmcnt(" #n ")" ::: "memory")
#define PG8_BAR __builtin_amdgcn_s_barrier()
#define PG8_SCHED __builtin_amdgcn_sched_barrier(0)
    Unit cur, nxt; int ui = 0;
    if (!S.next(0, cur)) return;
    f32x4 acc[2][2][4][2];
#pragma unroll
    for (int a = 0; a < 2; ++a)
#pragma unroll
        for (int b = 0; b < 2; ++b)
#pragma unroll
            for (int m = 0; m < 4; ++m)
#pragma unroll
                for (int n = 0; n < 2; ++n) acc[a][b][m][n] = (f32x4){0.f, 0.f, 0.f, 0.f};
    bf16x8 At[4][2], B0[2][2], B1[2][2];
    const char* cA = (const char*)g.A + (size_t)cur.pm * tstep + (size_t)cur.k0 * 2; const char* cB = (const char*)g.Bt + (size_t)cur.pn * tstep + (size_t)cur.k0 * 2;
    S.a_ready(cur);
    if constexpr (SP2) {
        PG8_STAGE(PG8_SB(0, 0), cB, voffB); PG8_STAGE(PG8_SB(0, 1), cB + hstep, voffB); PG8_STAGE(PG8_SA(0, 0), cA, voffA); PG8_STAGE(PG8_SA(0, 1), cA + hstep, voffA);
        if (wr == 1) PG8_BAR;
        PG8_WAIT_V(2); PG8_BAR;
        PG8_STAGE(PG8_SB(1, 0), cB + kstep, voffB); PG8_STAGE(PG8_SA(1, 0), cA + kstep, voffA); PG8_STAGE(PG8_SB(1, 1), cB + hstep + kstep, voffB);
        PG8_WAIT_V(6); PG8_BAR;
    } else {
        PG8_STAGE(PG8_SB(0, 0), cB, voffB); PG8_STAGE(PG8_SA(0, 0), cA, voffA); PG8_STAGE(PG8_SB(0, 1), cB + hstep, voffB); PG8_STAGE(PG8_SA(0, 1), cA + hstep, voffA);
        if (wr == 1) PG8_BAR;
        PG8_WAIT_V(4); PG8_BAR;
        PG8_STAGE(PG8_SB(1, 0), cB + kstep, voffB); PG8_STAGE(PG8_SA(1, 0), cA + kstep, voffA); PG8_STAGE(PG8_SB(1, 1), cB + hstep + kstep, voffB);
        PG8_WAIT_V(6); PG8_BAR;
    }
    for (;;) {
        const bool has_next = S.next(ui + 1, nxt);
        const char* nA = has_next ? (const char*)g.A + (size_t)nxt.pm * tstep + (size_t)nxt.k0 * 2 : cA; const char* nB = has_next ? (const char*)g.Bt + (size_t)nxt.pn * tstep + (size_t)nxt.k0 * 2 : cB;
        const int nt = cur.nt;
        for (int t = 0; t < nt; t += 2) {
            const bool last = (t == nt - 2);
            const char* a1 = cA + (size_t)(t + 1) * kstep;
            const char* a2 = last ? nA : cA + (size_t)(t + 2) * kstep; const char* b2 = last ? nB : cB + (size_t)(t + 2) * kstep;
            const char* a3 = a2 + kstep; const char* b3 = b2 + kstep;
            if (last && has_next) S.a_ready(nxt);
            if constexpr (SP2) {
            PG8_LDB(B0, 0, 0); PG8_LDB(B1, 0, 1); PG8_SCHED; PG8_LDA(At, 0, 0); PG8_STAGE(PG8_SA(1, 1), a1 + hstep, voffA);
            PG8_WAIT_V(8); PG8_WAIT_L(0); PG8_BAR; PG8_MMA(0, 0, At, B0); PG8_MMA(0, 1, At, B1); PG8_BAR; PG8_SCHED;
            PG8_LDA(At, 0, 1); PG8_STAGE(PG8_SB(0, 0), b2, voffB); PG8_STAGE(PG8_SB(0, 1), b2 + hstep, voffB); PG8_STAGE(PG8_SA(0, 0), a2, voffA);
            PG8_WAIT_V(8); PG8_WAIT_L(0); PG8_BAR; PG8_MMA(1, 0, At, B0); PG8_MMA(1, 1, At, B1); PG8_BAR; PG8_SCHED;
            PG8_LDB(B0, 1, 0); PG8_LDB(B1, 1, 1); PG8_SCHED; PG8_LDA(At, 1, 0); PG8_STAGE(PG8_SA(0, 1), a2 + hstep, voffA);
            PG8_WAIT_V(8); PG8_WAIT_L(0); PG8_BAR; PG8_MMA(0, 0, At, B0); PG8_MMA(0, 1, At, B1); PG8_BAR; PG8_SCHED;
            PG8_LDA(At, 1, 1); PG8_STAGE(PG8_SB(1, 0), b3, voffB); PG8_STAGE(PG8_SB(1, 1), b3 + hstep, voffB); PG8_STAGE(PG8_SA(1, 0), a3, voffA);
            PG8_WAIT_V(8); PG8_WAIT_L(0); PG8_BAR; PG8_MMA(1, 0, At, B0); PG8_MMA(1, 1, At, B1); PG8_BAR; PG8_SCHED;
            } else {
            PG8_LDB(B0, 0, 0); PG8_SCHED; PG8_LDA(At, 0, 0); PG8_STAGE(PG8_SA(1, 1), a1 + hstep, voffA);
            PG8_WAIT_L(8); PG8_BAR; PG8_WAIT_L(0); PG8_MMA(0, 0, At, B0); PG8_BAR; PG8_SCHED;
            PG8_LDB(B1, 0, 1); PG8_STAGE(PG8_SB(0, 0), b2, voffB);
            PG8_BAR; PG8_WAIT_L(0); PG8_MMA(0, 1, At, B1); PG8_BAR;
            PG8_LDA(At, 0, 1); PG8_STAGE(PG8_SA(0, 0), a2, voffA);
            PG8_BAR; PG8_WAIT_L(0); PG8_MMA(1, 0, At, B0); PG8_BAR; PG8_SCHED;
            PG8_STAGE(PG8_SB(0, 1), b2 + hstep, voffB);
            PG8_WAIT_V(6); PG8_BAR; PG8_MMA(1, 1, At, B1); PG8_BAR;
            PG8_LDB(B0, 1, 0); PG8_SCHED; PG8_LDA(At, 1, 0); PG8_STAGE(PG8_SA(0, 1), a2 + hstep, voffA);
            PG8_WAIT_L(8); PG8_BAR; PG8_WAIT_L(0); PG8_MMA(0, 0, At, B0); PG8_BAR; PG8_SCHED;
            PG8_LDB(B1, 1, 1); PG8_STAGE(PG8_SB(1, 0), b3, voffB);
            PG8_BAR; PG8_WAIT_L(0); PG8_MMA(0, 1, At, B1); PG8_BAR;
            PG8_LDA(At, 1, 1); PG8_STAGE(PG8_SA(1, 0), a3, voffA);
            PG8_BAR; PG8_WAIT_L(0); PG8_MMA(1, 0, At, B0); PG8_BAR; PG8_SCHED;
            PG8_STAGE(PG8_SB(1, 1), b3 + hstep, voffB);
            PG8_WAIT_V(6); PG8_BAR; PG8_MMA(1, 1, At, B1); PG8_BAR;
            }
        }
        if constexpr (ALIGN_EPI) { if (wr == 0) PG8_BAR; }
        if constexpr (!Epi::AFTER_DRAIN) { E(acc, cur, wr, wc, fr, fq); S.done(cur); }
        if (!has_next) break;
#pragma unroll
        for (int a = 0; a < 2; ++a)
#pragma unroll
            for (int b = 0; b < 2; ++b)
#pragma unroll
                for (int m = 0; m < 4; ++m)
#pragma unroll
                    for (int n = 0; n < 2; ++n) acc[a][b][m][n] = (f32x4){0.f, 0.f, 0.f, 0.f};
        cur = nxt; cA = nA; cB = nB; ++ui;
        if constexpr (ALIGN_EPI) { if (wr == 1) PG8_BAR; }
    }
    PG8_WAIT_V(0);
    if constexpr (!ALIGN_EPI) { if (wr == 0) PG8_BAR; }
    PG8_BAR;
    if constexpr (Epi::AFTER_DRAIN) { E.fused(acc, cur, wr, wc, fr, fq, lds, wid, lane); S.done(cur); }
#undef PG8_SA
#undef PG8_SB
#undef PG8_STAGE
#undef PG8_LDA
#undef PG8_LDB
#undef PG8_MMA
#undef PG8_WAIT_V
#undef PG8_WAIT_L
#undef PG8_BAR
#undef PG8_SCHED
}
}

#define LAS __attribute__((address_space(3)))
typedef unsigned short bf16_t;
typedef short bf16x8 __attribute__((ext_vector_type(8)));
typedef float f32x4 __attribute__((ext_vector_type(4)));
typedef float f32x2 __attribute__((ext_vector_type(2)));
typedef float f32x16 __attribute__((ext_vector_type(16)));
typedef unsigned u32x4 __attribute__((ext_vector_type(4)));
typedef unsigned u32x2 __attribute__((ext_vector_type(2)));

constexpr int DM = 1024, SEQ = 8192, NB = 2, MP = NB * SEQ, DB = 32, DT = 8, MS = DB * DT, MROWS = MP + MS;
constexpr int NIN = 2560, NQKV = 4608, DFF = 4096, CW = 512;
constexpr float ALPHA = 1.681792830507429f;
constexpr float LN_EPS = 1e-5f, LOG2E = 1.4426950408889634f;
constexpr int NWAVES = 8, NTHR = 512;
constexpr int LDS_BYTES = 147456;

constexpr size_t MiB = 1u << 20;
__host__ __device__ constexpr size_t WS_WIN(int i) { return (0 + 5 * (size_t)i) * MiB; }
__host__ __device__ constexpr size_t WS_WOUT(int i) { return (10 + 2 * (size_t)i) * MiB; }
__host__ __device__ constexpr size_t WS_WQKV(int i) { return (14 + 9 * (size_t)i) * MiB; }
__host__ __device__ constexpr size_t WS_WOC(int i) { return (32 + (size_t)i) * MiB; }
__host__ __device__ constexpr size_t WS_WUP(int l) { return (34 + 8 * (size_t)l) * MiB; }
__host__ __device__ constexpr size_t WS_WDN(int l) { return (66 + 8 * (size_t)l) * MiB; }
constexpr size_t WS_XF = 98 * MiB, WS_XB = 163 * MiB, WS_AB = 196 * MiB, WS_BIG = 229 * MiB, WS_OG = 376 * MiB, WS_LSE = 425 * MiB, WS_END = 427 * MiB;
static_assert((size_t)MROWS * DM * 4 == 65 * MiB, "XF size");

constexpr size_t O_Y = 0, O_CONVP = 17039360, O_CONVS = O_CONVP + 4096, O_CHV = O_CONVS + 65536, O_KVP0 = O_CHV + 262144, O_KVP1 = O_KVP0 + 524288,
                 O_KVP2 = O_KVP1 + 2097152, O_KVS0 = O_KVP2 + 8388608, O_KVS1 = O_KVS0 + 8388608, O_KVS2 = O_KVS1 + 33554432, O_END = O_KVS2 + 134217728;
static_assert(O_END == 204541952, "out size");

struct Args { const float* in[21]; float* out; unsigned char* ws; int pad0, pad1; };
typedef const __attribute__((address_space(4))) Args* ArgP;

__device__ __forceinline__ float bf2f(unsigned short b) { return __uint_as_float((unsigned)b << 16); }
__device__ __forceinline__ unsigned pk2(float lo, float hi) { return pg8::cvt_pk_bf16(lo, hi); }
__device__ __forceinline__ float wave_sum(float v) {
#pragma unroll
    for (int o = 1; o < 64; o <<= 1) v += __shfl_xor(v, o);
    return v;
}
__device__ __forceinline__ void unpack8(const u32x4 w, float* f) {
    f[0] = __uint_as_float(w.x << 16); f[1] = __uint_as_float(w.x & 0xffff0000u); f[2] = __uint_as_float(w.y << 16); f[3] = __uint_as_float(w.y & 0xffff0000u);
    f[4] = __uint_as_float(w.z << 16); f[5] = __uint_as_float(w.z & 0xffff0000u); f[6] = __uint_as_float(w.w << 16); f[7] = __uint_as_float(w.w & 0xffff0000u);
}
#define WAVE_LDS_FENCE() do { asm volatile("s_waitcnt lgkmcnt(0)" ::: "memory"); __builtin_amdgcn_wave_barrier(); } while (0)

__device__ __forceinline__ float gelu_tanh(float x) {
    const float u = x * (0.7978845608028654f + 0.035677408136300125f * x * x);
    const float e = __builtin_amdgcn_exp2f(-2.0f * LOG2E * u);
    return x * __builtin_amdgcn_rcpf(1.0f + e);
}
template <int ACT  > struct EpiAct {
    static constexpr bool PERM = true, AFTER_DRAIN = false;
    bf16_t* O; int ldc;
    __device__ __forceinline__ void operator()(const pg8::f32x4 (&acc)[2][2][4][2], const pg8::Unit& u, int wr, int wc, int fr, int fq) const {
        const int row0 = u.pm * 256 + wr * 64 + fr, col0 = u.pn * 256 + wc * 32 + 8 * fq;
        const bool dog = (ACT == 1) && (u.pn < 4);
#pragma unroll
        for (int ai = 0; ai < 2; ++ai)
#pragma unroll
            for (int m = 0; m < 4; ++m) { bf16_t* rowp = O + (size_t)(row0 + ai * 128 + m * 16) * ldc + col0;
#pragma unroll
                for (int bj = 0; bj < 2; ++bj) { pg8::f32x4 v0 = acc[ai][bj][m][0], v1 = acc[ai][bj][m][1];
                    if (ACT == 1) { if (dog) {
#pragma unroll
                        for (int e = 0; e < 4; ++e) { v0[e] = gelu_tanh(v0[e]); v1[e] = gelu_tanh(v1[e]); } } }
                    if (ACT == 2) {
#pragma unroll
                        for (int e = 0; e < 4; ++e) { const float a = fmaxf(v0[e], 0.f), b = fmaxf(v1[e], 0.f); v0[e] = a * a; v1[e] = b * b; } }
                    u32x4 w; w.x = pk2(v0[0], v0[1]); w.y = pk2(v0[2], v0[3]); w.z = pk2(v1[0], v1[1]); w.w = pk2(v1[2], v1[3]);
                    *(u32x4*)(rowp + bj * 128) = w; } asm volatile("" ::: "memory"); }
    }
};
struct EpiRes {
    static constexpr bool PERM = true, AFTER_DRAIN = false;
    float* XF;
    __device__ __forceinline__ void operator()(const pg8::f32x4 (&acc)[2][2][4][2], const pg8::Unit& u, int wr, int wc, int fr, int fq) const {
        const int row0 = u.pm * 256 + wr * 64 + fr, col0 = u.pn * 256 + wc * 32 + 8 * fq;
        if (u.pm == 64) {
#pragma unroll
            for (int ai = 0; ai < 2; ++ai)
#pragma unroll
                for (int m = 0; m < 4; ++m) { float* rowp = XF + (size_t)(row0 + ai * 128 + m * 16) * DM + col0;
#pragma unroll
                    for (int bj = 0; bj < 2; ++bj)
#pragma unroll
                        for (int e = 0; e < 4; ++e) { __hip_atomic_fetch_add(rowp + bj * 128 + e, acc[ai][bj][m][0][e], __ATOMIC_RELAXED, __HIP_MEMORY_SCOPE_AGENT);
                            __hip_atomic_fetch_add(rowp + bj * 128 + 4 + e, acc[ai][bj][m][1][e], __ATOMIC_RELAXED, __HIP_MEMORY_SCOPE_AGENT); } }
            return;
        }
#pragma unroll
        for (int ai = 0; ai < 2; ++ai)
#pragma unroll
            for (int m = 0; m < 4; ++m) { float* rowp = XF + (size_t)(row0 + ai * 128 + m * 16) * DM + col0;
#pragma unroll
                for (int bj = 0; bj < 2; ++bj) { f32x4* p = (f32x4*)(rowp + bj * 128);
                    f32x4 a = p[0], b = p[1];
#pragma unroll
                    for (int e = 0; e < 4; ++e) { a[e] = ALPHA * a[e] + acc[ai][bj][m][0][e]; b[e] = ALPHA * b[e] + acc[ai][bj][m][1][e]; }
                    p[0] = a; p[1] = b; asm volatile("" ::: "memory"); } }
    }
};

struct MixOrder {
    int G, c, KT, npieces; pg8::StaticOrder P;
    __device__ void init(int G_, int c_, int K_) { G = G_; c = c_; KT = K_ / 64; npieces = 4 * (K_ / 256); P.init(MP, DM, 1, 0, K_); }
    __device__ bool next(int i, pg8::Unit& u) const {
        const int Lx = i * G + c;
        if (Lx < npieces) { u.pm = 64; u.pn = Lx & 3; u.k0 = (Lx >> 2) * 256; u.nt = 4; return true; }
        return P.next(Lx - npieces, u);
    }
    __device__ __forceinline__ void a_ready(const pg8::Unit&) const {}
    __device__ __forceinline__ void done(const pg8::Unit&) const {}
};

__device__ __forceinline__ void p0_transpose_item(const float* W, int K, int N, bf16_t* WT, LAS float* scr, int item, int lane) {
    const int nblk = N / 32, kb = item / nblk, nb = item % nblk, k0 = 64 * kb, n0 = 32 * nb;
#pragma unroll 8
    for (int i = 0; i < 32; ++i) { const int kk = 2 * i + (lane >> 5); scr[kk * 33 + (lane & 31)] = W[(size_t)(k0 + kk) * N + n0 + (lane & 31)]; }
    asm volatile("s_waitcnt lgkmcnt(0)" ::: "memory");
    const int c = lane & 7;
#pragma unroll
    for (int j = 0; j < 4; ++j) { const int n = (lane >> 3) + 8 * j; const LAS float* s = scr + (8 * c) * 33 + n;
        u32x4 o; o.x = pk2(s[0 * 33], s[1 * 33]); o.y = pk2(s[2 * 33], s[3 * 33]); o.z = pk2(s[4 * 33], s[5 * 33]); o.w = pk2(s[6 * 33], s[7 * 33]);
        *(u32x4*)(WT + (size_t)(n0 + n) * K + k0 + 8 * c) = o; }
    asm volatile("s_waitcnt lgkmcnt(0)" ::: "memory");
}

__device__ __forceinline__ void prologue(ArgP ap, LAS unsigned char* lds, int gw, int NGW, int wave, int lane) {
    LAS float* scr = (LAS float*)(lds + wave * 16384);
    unsigned char* ws = ap->ws;
#pragma unroll 1
    for (int mt = 0; mt < 16; ++mt) {
        const float* src; bf16_t* dst; int K, N;
        if (mt < 8) { const int i = mt & 1, k = mt >> 1;
            if (k == 0) { src = ap->in[6] + (size_t)i * DM * NIN; dst = (bf16_t*)(ws + WS_WIN(i)); K = DM; N = NIN; }
            else if (k == 1) { src = ap->in[12] + (size_t)i * DM * DM; dst = (bf16_t*)(ws + WS_WOUT(i)); K = DM; N = DM; }
            else if (k == 2) { src = ap->in[13] + (size_t)i * DM * NQKV; dst = (bf16_t*)(ws + WS_WQKV(i)); K = DM; N = NQKV; }
            else { src = ap->in[14] + (size_t)i * CW * DM; dst = (bf16_t*)(ws + WS_WOC(i)); K = CW; N = DM; }
        } else if (mt < 12) { const int l = mt - 8; src = ap->in[19] + (size_t)l * DM * DFF; dst = (bf16_t*)(ws + WS_WUP(l)); K = DM; N = DFF; }
        else { const int l = mt - 12; src = ap->in[20] + (size_t)l * DFF * DM; dst = (bf16_t*)(ws + WS_WDN(l)); K = DFF; N = DM; }
        const int items = (K / 64) * (N / 32);
        for (int it = gw; it < items; it += NGW) p0_transpose_item(src, K, N, dst, scr, it, lane);
    }
    const int gt = gw * 64 + lane, NGT = NGW * 64;
    {
        float* XF = (float*)(ws + WS_XF); bf16_t* XB = (bf16_t*)(ws + WS_XB);
        for (int u = gt; u < MROWS * 256; u += NGT) {
            const f32x4 v = (u < MP * 256) ? ((const f32x4*)ap->in[0])[u] : ((const f32x4*)ap->in[1])[u - MP * 256];
            ((f32x4*)XF)[u] = (u < MP * 256) ? v : v * ALPHA; u32x2 w; w.x = pk2(v[0], v[1]); w.y = pk2(v[2], v[3]); ((u32x2*)XB)[u] = w;
        }
    }
#pragma unroll 1
    for (int g = 0; g < 3; ++g) {
        const int L = 128 << (2 * g); const size_t blk4 = (size_t)L * 256, keep4 = (size_t)(L - 8) * 256, n4 = (size_t)2 * DB * blk4;
        const f32x4* src = (const f32x4*)ap->in[3 + g]; f32x4* dst = (f32x4*)(ap->out + (g == 0 ? O_KVS0 : g == 1 ? O_KVS1 : O_KVS2));
        for (size_t u = gt; u < n4; u += NGT) { const size_t off = u & (blk4 - 1);
            if (off < keep4) __builtin_nontemporal_store(__builtin_nontemporal_load(src + u + 8 * 256), dst + u); }
    }
}

__device__ __forceinline__ void ln_phase(unsigned char* ws, const float* gam, const float* bet, float* outp, int gw, int NGW, int lane) {
    float* XF = (float*)(ws + WS_XF); bf16_t* XB = (bf16_t*)(ws + WS_XB);
    f32x4 g4[4], b4[4];
#pragma unroll
    for (int j = 0; j < 4; ++j) { g4[j] = ((const f32x4*)gam)[lane + 64 * j]; b4[j] = ((const f32x4*)bet)[lane + 64 * j]; }
    for (int row = gw; row < MROWS; row += NGW) {
        f32x4* xr = (f32x4*)(XF + (size_t)row * DM) + lane;
        f32x4 v[4]; float s = 0.f;
#pragma unroll
        for (int j = 0; j < 4; ++j) { v[j] = xr[64 * j]; s += (v[j][0] + v[j][1]) + (v[j][2] + v[j][3]); }
        const float mean = wave_sum(s) * (1.f / DM); float s2 = 0.f;
#pragma unroll
        for (int j = 0; j < 4; ++j) { v[j] = v[j] - mean; s2 += (v[j][0] * v[j][0] + v[j][1] * v[j][1]) + (v[j][2] * v[j][2] + v[j][3] * v[j][3]); }
        const float rstd = 1.f / sqrtf(wave_sum(s2) * (1.f / DM) + LN_EPS);
        u32x2* ob = (u32x2*)(XB + (size_t)row * DM) + lane;
#pragma unroll
        for (int j = 0; j < 4; ++j) { f32x4 y = v[j] * rstd * g4[j] + b4[j];
            if (outp) ((f32x4*)(outp + (size_t)row * DM))[lane + 64 * j] = y; else xr[64 * j] = (row >= MP) ? y * ALPHA : y;
            u32x2 w; w.x = pk2(y[0], y[1]); w.y = pk2(y[2], y[3]); ob[64 * j] = w; }
    }
}

__device__ __forceinline__ void mix_prompt(ArgP ap, LAS unsigned char* lds, int il, int chunk, int g, int tid, int wave, int lane) {
    const bf16_t* Z = (const bf16_t*)(ap->ws + WS_BIG); bf16_t* AB = (bf16_t*)(ap->ws + WS_AB);
    const int row0 = chunk * 128;
    LAS f32x2* stats = (LAS f32x2*)lds; LAS unsigned char* vnT = lds + 1024;
#pragma unroll 4
    for (int k = 0; k < 16; ++k) { const int r = wave * 16 + k;
        const u32x4 w = *(const u32x4*)(Z + (size_t)(row0 + r) * NIN + 512 + lane * 8); float f[8]; unpack8(w, f);
        float s = 0.f;
#pragma unroll
        for (int e = 0; e < 8; ++e) s += f[e];
        const float mean = wave_sum(s) * (1.f / 512.f); float q = 0.f;
#pragma unroll
        for (int e = 0; e < 8; ++e) { const float d = f[e] - mean; q += d * d; }
        const float rstd = 1.f / sqrtf(wave_sum(q) * (1.f / 512.f) + LN_EPS);
        if (lane == 0) stats[r] = (f32x2){mean, rstd}; }
    __syncthreads();
    const float* lg = ap->in[7] + il * 512 + g * 128; const float* lb = ap->in[8] + il * 512 + g * 128;
#pragma unroll
    for (int k = 0; k < 2; ++k) { const int id = tid + 512 * k, p = id & 63, cc = id >> 6;
        const u32x4 w0 = *(const u32x4*)(Z + (size_t)(row0 + 2 * p) * NIN + 512 + g * 128 + cc * 8), w1 = *(const u32x4*)(Z + (size_t)(row0 + 2 * p + 1) * NIN + 512 + g * 128 + cc * 8);
        float f0[8], f1[8]; unpack8(w0, f0); unpack8(w1, f1);
        const f32x2 s0 = stats[2 * p], s1 = stats[2 * p + 1];
#pragma unroll
        for (int e = 0; e < 8; ++e) { const float gg = lg[cc * 8 + e], bb = lb[cc * 8 + e];
            const float y0 = (f0[e] - s0.x) * s0.y * gg + bb, y1 = (f1[e] - s1.x) * s1.y * gg + bb;
            *(LAS unsigned*)(vnT + ((cc * 8 + e) * 136 + 2 * p) * 2) = pk2(y0, y1); } }
    __syncthreads();
    {
        const int fr = lane & 15, fq = lane >> 4, i = wave * 16 + fr, nks = (wave >> 1) + 1;
        const float* Wr = ap->in[9] + ((size_t)(il * 4 + g) * 128 + i) * 128;
        pg8::f32x4 acc[8];
#pragma unroll
        for (int nt = 0; nt < 8; ++nt) acc[nt] = (pg8::f32x4){0.f, 0.f, 0.f, 0.f};
        for (int ks = 0; ks < nks; ++ks) { const int j0 = 32 * ks + 8 * fq;
            const f32x4 wa = *(const f32x4*)(Wr + j0), wb = *(const f32x4*)(Wr + j0 + 4);
            float wf[8] = {wa[0], wa[1], wa[2], wa[3], wb[0], wb[1], wb[2], wb[3]};
#pragma unroll
            for (int e = 0; e < 8; ++e) wf[e] = (j0 + e <= i) ? wf[e] : 0.f;
            u32x4 aw; aw.x = pk2(wf[0], wf[1]); aw.y = pk2(wf[2], wf[3]); aw.z = pk2(wf[4], wf[5]); aw.w = pk2(wf[6], wf[7]);
            const bf16x8 af = __builtin_bit_cast(bf16x8, aw);
#pragma unroll
            for (int nt = 0; nt < 8; ++nt) { const bf16x8 bfr = *(const LAS bf16x8*)(vnT + ((16 * nt + fr) * 136 + 32 * ks + 8 * fq) * 2);
                acc[nt] = __builtin_amdgcn_mfma_f32_16x16x32_bf16(bfr, af, acc[nt], 0, 0, 0); } }
        const float bs = ap->in[10][(il * 4 + g) * 128 + i];
        const bf16_t* up = Z + (size_t)(row0 + i) * NIN + g * 128 + 4 * fq; bf16_t* op = AB + (size_t)(row0 + i) * DM + g * 128 + 4 * fq;
#pragma unroll
        for (int nt = 0; nt < 8; ++nt) { const u32x2 uw = *(const u32x2*)(up + 16 * nt);
            const float u0 = __uint_as_float(uw.x << 16), u1 = __uint_as_float(uw.x & 0xffff0000u), u2 = __uint_as_float(uw.y << 16), u3 = __uint_as_float(uw.y & 0xffff0000u);
            u32x2 o; o.x = pk2(u0 * (acc[nt][0] + bs), u1 * (acc[nt][1] + bs)); o.y = pk2(u2 * (acc[nt][2] + bs), u3 * (acc[nt][3] + bs));
            *(u32x2*)(op + 16 * nt) = o; }
    }
    {
        const float* cw = ap->in[11] + (size_t)il * 3 * 512;
#pragma unroll 1
        for (int k = 0; k < 4; ++k) { const int id = tid + 512 * k, cc = id & 15, r = id >> 4, c0 = g * 128 + cc * 8, row = row0 + r, t = row & (SEQ - 1);
            const bf16_t* zr = Z + (size_t)row * NIN + c0;
            float ch0[8], ch1[8], ch2[8], bg[8], x[8], y[8];
            unpack8(*(const u32x4*)(zr + 1536), x); unpack8(*(const u32x4*)(zr + 2048), y);
#pragma unroll
            for (int e = 0; e < 8; ++e) ch2[e] = x[e] * y[e];
            if (t >= 1) { unpack8(*(const u32x4*)(zr - NIN + 1536), x); unpack8(*(const u32x4*)(zr - NIN + 2048), y);
#pragma unroll
                for (int e = 0; e < 8; ++e) ch1[e] = x[e] * y[e]; } else {
#pragma unroll
                for (int e = 0; e < 8; ++e) ch1[e] = 0.f; }
            if (t >= 2) { unpack8(*(const u32x4*)(zr - 2 * NIN + 1536), x); unpack8(*(const u32x4*)(zr - 2 * NIN + 2048), y);
#pragma unroll
                for (int e = 0; e < 8; ++e) ch0[e] = x[e] * y[e]; } else {
#pragma unroll
                for (int e = 0; e < 8; ++e) ch0[e] = 0.f; }
            unpack8(*(const u32x4*)(zr + 1024), bg);
            float o[8];
#pragma unroll
            for (int e = 0; e < 8; ++e) o[e] = bg[e] * (cw[c0 + e] * ch0[e] + cw[512 + c0 + e] * ch1[e] + cw[1024 + c0 + e] * ch2[e]);
            u32x4 w; w.x = pk2(o[0], o[1]); w.y = pk2(o[2], o[3]); w.z = pk2(o[4], o[5]); w.w = pk2(o[6], o[7]);
            *(u32x4*)(AB + (size_t)row * DM + 512 + c0) = w;
            if (t >= SEQ - 2) { float* cp = ap->out + O_CONVP + ((size_t)(il * 2 + (row >> 13)) * 2 + (t - (SEQ - 2))) * 512 + c0;
                *(f32x4*)cp = (f32x4){ch2[0], ch2[1], ch2[2], ch2[3]}; *(f32x4*)(cp + 4) = (f32x4){ch2[4], ch2[5], ch2[6], ch2[7]}; } }
    }
    __syncthreads();
}

__device__ __forceinline__ void mix_sample(ArgP ap, LAS unsigned char* lds, int il, int db, int tid, int wave, int lane) {
    const bf16_t* Z = (const bf16_t*)(ap->ws + WS_BIG); bf16_t* AB = (bf16_t*)(ap->ws + WS_AB);
    const int R0 = MP + db * 8;
    LAS float* vnS = (LAS float*)lds;
    {
        const u32x4 w = *(const u32x4*)(Z + (size_t)(R0 + wave) * NIN + 512 + lane * 8); float f[8]; unpack8(w, f);
        float s = 0.f;
#pragma unroll
        for (int e = 0; e < 8; ++e) s += f[e];
        const float mean = wave_sum(s) * (1.f / 512.f); float q = 0.f;
#pragma unroll
        for (int e = 0; e < 8; ++e) { const float d = f[e] - mean; q += d * d; }
        const float rstd = 1.f / sqrtf(wave_sum(q) * (1.f / 512.f) + LN_EPS);
        float* cv = ap->out + O_CHV + ((size_t)(il * DB + db) * 8 + wave) * 512 + lane * 8;
#pragma unroll
        for (int e = 0; e < 8; ++e) { const float y = (f[e] - mean) * rstd * ap->in[7][il * 512 + lane * 8 + e] + ap->in[8][il * 512 + lane * 8 + e]; vnS[wave * 512 + lane * 8 + e] = y; cv[e] = y; }
    }
    __syncthreads();
    {
        const int c = tid, g = c >> 7;
        const float* Wg = ap->in[9] + (size_t)(il * 4 + g) * 128 * 128;
        float vv[8];
#pragma unroll
        for (int j = 0; j < 8; ++j) vv[j] = vnS[j * 512 + c];
#pragma unroll
        for (int i = 0; i < 8; ++i) { float y = ap->in[10][(il * 4 + g) * 128 + i];
#pragma unroll
            for (int j = 0; j < 8; ++j) if (j <= i) y += Wg[i * 128 + j] * vv[j];
            const float u = bf2f(Z[(size_t)(R0 + i) * NIN + c]);
            AB[(size_t)(R0 + i) * DM + c] = (bf16_t)(pk2(u * y, 0.f) & 0xffffu); }
        const float* cw = ap->in[11] + (size_t)il * 3 * 512; const float w0 = cw[c], w1 = cw[512 + c], w2 = cw[1024 + c];
        const float* st = ap->in[2] + (size_t)(il * DB + db) * 2 * 512;
        float c0 = st[c], c1 = st[512 + c];
#pragma unroll
        for (int t = 0; t < 8; ++t) { const bf16_t* zr = Z + (size_t)(R0 + t) * NIN + c;
            const float c2 = bf2f(zr[1536]) * bf2f(zr[2048]);
            const float o = bf2f(zr[1024]) * (w0 * c0 + w1 * c1 + w2 * c2);
            AB[(size_t)(R0 + t) * DM + 512 + c] = (bf16_t)(pk2(o, 0.f) & 0xffffu);
            c0 = c1; c1 = c2; }
        float* cs = ap->out + O_CONVS + (size_t)(il * DB + db) * 2 * 512;
        cs[c] = c0; cs[512 + c] = c1;
    }
    __syncthreads();
}

__device__ __forceinline__ void att_prompt_tile(unsigned char* ws, LAS unsigned char* vt, int b, int g, int h, int r, int qt, int lane) {
    const bf16_t* QKV = (const bf16_t*)(ws + WS_BIG); bf16_t* OG = (bf16_t*)(ws + WS_OG); float* LSE = (float*)(ws + WS_LSE);
    const int d = 1 << (2 * g), ql = lane & 31, hi = lane >> 5, q0 = qt * 32, kb = q0 - 128;
    const bf16_t* base = QKV + (size_t)(b * SEQ + r) * NQKV + g * 512 + h * 64;
    const size_t ms = (size_t)d * NQKV;
    bf16x8 qf[4];
    { const bf16_t* qp = base + (size_t)(q0 + ql) * ms + hi * 8;
#pragma unroll
      for (int d0 = 0; d0 < 4; ++d0) qf[d0] = *(const bf16x8*)(qp + d0 * 16); }
    const int keyl = (ql & 0x13) | ((ql & 4) << 1) | ((ql & 8) >> 1);
    const float sc = 0.125f * LOG2E, sl = exp2f(-(float)(h + 1)) * (float)d * LOG2E;
    const int t0 = ql - 8 * hi;
    float m = -1e30f, l = 0.f;
    f32x16 O0 = {0.f, 0.f, 0.f, 0.f, 0.f, 0.f, 0.f, 0.f, 0.f, 0.f, 0.f, 0.f, 0.f, 0.f, 0.f, 0.f}, O1 = O0;
    const int sp = lane & 15, scn = lane >> 4;
    const int kt0 = kb < 0 ? ((-kb) >> 5) : 0;
    const bf16_t* kp = base + 1536 + (size_t)(kb + 32 * kt0 + keyl) * ms + hi * 8;
    const bf16_t* vp = base + 3072 + (size_t)(kb + 32 * kt0 + 2 * sp) * ms + scn * 8;
#pragma unroll 1
    for (int kt = kt0; kt < 5; ++kt, kp += 32 * ms, vp += 32 * ms) {
        bf16x8 kf[4];
#pragma unroll
        for (int d0 = 0; d0 < 4; ++d0) kf[d0] = *(const bf16x8*)(kp + d0 * 16);
        const u32x4 va0 = *(const u32x4*)(vp), va1 = *(const u32x4*)(vp + ms), vb0 = *(const u32x4*)(vp + 32), vb1 = *(const u32x4*)(vp + ms + 32);
        f32x16 S = {0.f, 0.f, 0.f, 0.f, 0.f, 0.f, 0.f, 0.f, 0.f, 0.f, 0.f, 0.f, 0.f, 0.f, 0.f, 0.f};
#pragma unroll
        for (int d0 = 0; d0 < 4; ++d0) S = __builtin_amdgcn_mfma_f32_32x32x16_bf16(kf[d0], qf[d0], S, 0, 0, 0);
        float tm = -1e30f;
#pragma unroll
        for (int rr = 0; rr < 16; ++rr) { const int crr = (rr & 7) + 16 * (rr >> 3), delta = 128 - 32 * kt + t0 - crr;
            float sv = S[rr] * sc - sl * (float)delta;
            sv = ((unsigned)delta <= 128u) ? sv : -1e30f; asm volatile("" : "+v"(sv));
            S[rr] = sv; tm = fmaxf(tm, sv); }
        tm = fmaxf(tm, __shfl_xor(tm, 32));
        const float mn = fmaxf(m, tm), corr = __builtin_amdgcn_exp2f(m - mn); m = mn;
        float ps = 0.f;
#pragma unroll
        for (int rr = 0; rr < 16; ++rr) { const float p = __builtin_amdgcn_exp2f(S[rr] - mn); ps += p; S[rr] = p; }
        l = l * corr + ps;
        O0 = O0 * corr; O1 = O1 * corr;
        bf16x8 pk[2];
#pragma unroll
        for (int j = 0; j < 2; ++j) { u32x4 w; w.x = pk2(S[8 * j + 0], S[8 * j + 1]); w.y = pk2(S[8 * j + 2], S[8 * j + 3]); w.z = pk2(S[8 * j + 4], S[8 * j + 5]); w.w = pk2(S[8 * j + 6], S[8 * j + 7]);
            pk[j] = __builtin_bit_cast(bf16x8, w); }
        WAVE_LDS_FENCE();
        { LAS unsigned char* wp = vt + ((scn * 8) * 40 + 2 * sp) * 2;
#define VT_ST(V0, V1, OFF) do { \
            *(LAS unsigned*)(wp + (OFF) + 0 * 80) = (V0.x & 0xffffu) | (V1.x << 16); *(LAS unsigned*)(wp + (OFF) + 1 * 80) = (V0.x >> 16) | (V1.x & 0xffff0000u); \
            *(LAS unsigned*)(wp + (OFF) + 2 * 80) = (V0.y & 0xffffu) | (V1.y << 16); *(LAS unsigned*)(wp + (OFF) + 3 * 80) = (V0.y >> 16) | (V1.y & 0xffff0000u); \
            *(LAS unsigned*)(wp + (OFF) + 4 * 80) = (V0.z & 0xffffu) | (V1.z << 16); *(LAS unsigned*)(wp + (OFF) + 5 * 80) = (V0.z >> 16) | (V1.z & 0xffff0000u); \
            *(LAS unsigned*)(wp + (OFF) + 6 * 80) = (V0.w & 0xffffu) | (V1.w << 16); *(LAS unsigned*)(wp + (OFF) + 7 * 80) = (V0.w >> 16) | (V1.w & 0xffff0000u); } while (0)
          VT_ST(va0, va1, 0); VT_ST(vb0, vb1, 32 * 80);
#undef VT_ST
        }
        WAVE_LDS_FENCE();
#pragma unroll
        for (int j = 0; j < 2; ++j) { const bf16x8 v0 = *(const LAS bf16x8*)(vt + (ql * 40 + 16 * j + 8 * hi) * 2), v1 = *(const LAS bf16x8*)(vt + ((32 + ql) * 40 + 16 * j + 8 * hi) * 2);
            O0 = __builtin_amdgcn_mfma_f32_32x32x16_bf16(v0, pk[j], O0, 0, 0, 0); O1 = __builtin_amdgcn_mfma_f32_32x32x16_bf16(v1, pk[j], O1, 0, 0, 0); }
    }
    l += __shfl_xor(l, 32);
    const float inv = 1.0f / l;
    const int row = b * SEQ + (q0 + ql) * d + r;
    bf16_t* op = OG + ((size_t)g * MROWS + row) * 512 + h * 64 + 4 * hi;
#pragma unroll
    for (int rr = 0; rr < 4; ++rr) { u32x2 w; w.x = pk2(O0[4 * rr] * inv, O0[4 * rr + 1] * inv); w.y = pk2(O0[4 * rr + 2] * inv, O0[4 * rr + 3] * inv); *(u32x2*)(op + 8 * rr) = w;
        u32x2 w2; w2.x = pk2(O1[4 * rr] * inv, O1[4 * rr + 1] * inv); w2.y = pk2(O1[4 * rr + 2] * inv, O1[4 * rr + 3] * inv); *(u32x2*)(op + 32 + 8 * rr) = w2; }
    if (hi == 0) LSE[((size_t)g * MROWS + row) * 8 + h] = m + __builtin_amdgcn_logf(l);
}

__device__ __forceinline__ void att_sample_query(ArgP ap, int il, int db, int g, int h, int t, int lane) {
    const bf16_t* QKV = (const bf16_t*)(ap->ws + WS_BIG); bf16_t* OG = (bf16_t*)(ap->ws + WS_OG); float* LSE = (float*)(ap->ws + WS_LSE);
    const int d = 1 << (2 * g), L = 128 << (2 * g), kg = lane >> 4, dl = lane & 15;
    const float* cache = ap->in[3 + g] + ((size_t)(il * DB + db) * L) * 1024 + h * 64 + 4 * dl;
    const int R = MP + db * 8 + t;
    const bf16_t* nrow = QKV + (size_t)(MP + db * 8) * NQKV + g * 512 + h * 64 + 4 * dl;
    float q[4];
    { const u32x2 w = *(const u32x2*)(nrow + (size_t)t * NQKV); q[0] = __uint_as_float(w.x << 16); q[1] = __uint_as_float(w.x & 0xffff0000u); q[2] = __uint_as_float(w.y << 16); q[3] = __uint_as_float(w.y & 0xffff0000u); }
    const float sc = 0.125f * LOG2E, sl = exp2f(-(float)(h + 1)) * (float)d * LOG2E;
    float m = -1e30f, l = 0.f, o[4] = {0.f, 0.f, 0.f, 0.f};
#pragma unroll 3
    for (int i = 0; i < 33; ++i) { const int s = kg + 4 * i; const bool valid = s <= 128; const int sv = valid ? s : 128;
        const int idx = L + t - sv * d;
        float k[4], v[4];
        if (idx >= L) { const bf16_t* p = nrow + (size_t)(idx - L) * NQKV;
            const u32x2 kw = *(const u32x2*)(p + 1536), vw = *(const u32x2*)(p + 3072);
            k[0] = __uint_as_float(kw.x << 16); k[1] = __uint_as_float(kw.x & 0xffff0000u); k[2] = __uint_as_float(kw.y << 16); k[3] = __uint_as_float(kw.y & 0xffff0000u);
            v[0] = __uint_as_float(vw.x << 16); v[1] = __uint_as_float(vw.x & 0xffff0000u); v[2] = __uint_as_float(vw.y << 16); v[3] = __uint_as_float(vw.y & 0xffff0000u);
        } else { const f32x4 kk = *(const f32x4*)(cache + (size_t)idx * 1024), vv = *(const f32x4*)(cache + (size_t)idx * 1024 + 512);
            k[0] = kk[0]; k[1] = kk[1]; k[2] = kk[2]; k[3] = kk[3]; v[0] = vv[0]; v[1] = vv[1]; v[2] = vv[2]; v[3] = vv[3]; }
        float dot = (q[0] * k[0] + q[1] * k[1]) + (q[2] * k[2] + q[3] * k[3]);
        dot += __shfl_xor(dot, 1); dot += __shfl_xor(dot, 2); dot += __shfl_xor(dot, 4); dot += __shfl_xor(dot, 8);
        const float s2 = valid ? dot * sc - sl * (float)s : -1e30f;
        const float mn = fmaxf(m, s2), corr = __builtin_amdgcn_exp2f(m - mn), p = valid ? __builtin_amdgcn_exp2f(s2 - mn) : 0.f;
        l = l * corr + p;
#pragma unroll
        for (int e = 0; e < 4; ++e) o[e] = o[e] * corr + p * v[e];
        m = mn; }
    float M = fmaxf(m, __shfl_xor(m, 16)); M = fmaxf(M, __shfl_xor(M, 32));
    const float f = __builtin_amdgcn_exp2f(m - M);
    l *= f; l += __shfl_xor(l, 16); l += __shfl_xor(l, 32);
#pragma unroll
    for (int e = 0; e < 4; ++e) { o[e] *= f; o[e] += __shfl_xor(o[e], 16); o[e] += __shfl_xor(o[e], 32); }
    const float inv = 1.0f / l;
    if (kg == 0) { u32x2 w; w.x = pk2(o[0] * inv, o[1] * inv); w.y = pk2(o[2] * inv, o[3] * inv);
        *(u32x2*)(OG + ((size_t)g * MROWS + R) * 512 + h * 64 + 4 * dl) = w; }
    if (lane == 0) LSE[((size_t)g * MROWS + R) * 8 + h] = M + __builtin_amdgcn_logf(l);
}

__device__ __forceinline__ void att_phase(ArgP ap, LAS unsigned char* lds, int il, int gw, int NGW, int wave, int lane) {
    LAS unsigned char* vt = lds + wave * 5120;
    for (int sq = gw; sq < 3 * DB * 8 * 8; sq += NGW) { const int h = sq & 7, t = (sq >> 3) & 7, db = (sq >> 6) & 31, g = sq >> 11;
#ifndef SKIP_ATTS
        att_sample_query(ap, il, db, g, h, t, lane);
#endif
        }
    for (int wt = gw; wt < 2 * 3 * 8 * 256; wt += NGW) { const int idx = wt & 255, h = (wt >> 8) & 7, bg = wt >> 11, g = bg % 3, b = bg / 3;
        const int tpr = 256 >> (2 * g);
#ifndef SKIP_ATTP
        att_prompt_tile(ap->ws, vt, b, g, h, idx / tpr, idx % tpr, lane);
#endif
        }
}

__device__ __forceinline__ void merge_phase(ArgP ap, int il, int gt, int NGT) {
    const bf16_t* QKV = (const bf16_t*)(ap->ws + WS_BIG); const bf16_t* OG = (const bf16_t*)(ap->ws + WS_OG); const float* LSE = (const float*)(ap->ws + WS_LSE); bf16_t* O = (bf16_t*)(ap->ws + WS_AB);
    for (int u = gt; u < MROWS * 64; u += NGT) { const int row = u >> 6, c8 = u & 63, h = c8 >> 3;
        const float l0 = LSE[((size_t)0 * MROWS + row) * 8 + h], l1 = LSE[((size_t)1 * MROWS + row) * 8 + h], l2 = LSE[((size_t)2 * MROWS + row) * 8 + h];
        const float mx = fmaxf(l0, fmaxf(l1, l2));
        float w0 = __builtin_amdgcn_exp2f(l0 - mx), w1 = __builtin_amdgcn_exp2f(l1 - mx), w2 = __builtin_amdgcn_exp2f(l2 - mx);
        const float inv = 1.0f / (w0 + w1 + w2); w0 *= inv; w1 *= inv; w2 *= inv;
        float f0[8], f1[8], f2[8];
        unpack8(*(const u32x4*)(OG + ((size_t)0 * MROWS + row) * 512 + c8 * 8), f0); unpack8(*(const u32x4*)(OG + ((size_t)1 * MROWS + row) * 512 + c8 * 8), f1); unpack8(*(const u32x4*)(OG + ((size_t)2 * MROWS + row) * 512 + c8 * 8), f2);
        float o[8];
#pragma unroll
        for (int e = 0; e < 8; ++e) o[e] = w0 * f0[e] + w1 * f1[e] + w2 * f2[e];
        u32x4 w; w.x = pk2(o[0], o[1]); w.y = pk2(o[2], o[3]); w.z = pk2(o[4], o[5]); w.w = pk2(o[6], o[7]);
        *(u32x4*)(O + (size_t)row * 512 + c8 * 8) = w; }
#pragma unroll 1
    for (int g = 0; g < 3; ++g) { const int n = 128 << (2 * g); float* dst = ap->out + (g == 0 ? O_KVP0 : g == 1 ? O_KVP1 : O_KVP2) + (size_t)il * NB * n * 1024;
        for (int u = gt; u < NB * n * 128; u += NGT) { const int c8 = u & 63, kv = (u >> 6) & 1, rj = u >> 7, b = rj / n, j = rj - b * n;
            float f[8]; unpack8(*(const u32x4*)(QKV + (size_t)(b * SEQ + SEQ - n + j) * NQKV + (1 + kv) * 1536 + g * 512 + c8 * 8), f);
            float* p = dst + (size_t)rj * 1024 + kv * 512 + c8 * 8; *(f32x4*)p = (f32x4){f[0], f[1], f[2], f[3]}; *(f32x4*)(p + 4) = (f32x4){f[4], f[5], f[6], f[7]}; } }
#pragma unroll 1
    for (int g = 0; g < 3; ++g) { const int L = 128 << (2 * g); float* dst = ap->out + (g == 0 ? O_KVS0 : g == 1 ? O_KVS1 : O_KVS2) + (size_t)il * DB * L * 1024;
        for (int u = gt; u < DB * 8 * 128; u += NGT) { const int c8 = u & 63, kv = (u >> 6) & 1, t = (u >> 7) & 7, db = u >> 10;
            float f[8]; unpack8(*(const u32x4*)(QKV + (size_t)(MP + db * 8 + t) * NQKV + (1 + kv) * 1536 + g * 512 + c8 * 8), f);
            float* p = dst + ((size_t)db * L + L - 8 + t) * 1024 + kv * 512 + c8 * 8; *(f32x4*)p = (f32x4){f[0], f[1], f[2], f[3]}; *(f32x4*)(p + 4) = (f32x4){f[4], f[5], f[6], f[7]}; } }
}

#define RUN_GEMM(EPI, Aptr, Btptr, N_, K_, Eobj) do { pg8::Gemm g_{(const bf16_t*)(Aptr), (const bf16_t*)(Btptr), MROWS, (N_), (K_)}; pg8::StaticOrder S_; S_.init(MROWS, (N_), (int)gridDim.x, (int)blockIdx.x, (K_)); \
    pg8::gemm_phase<EPI, pg8::StaticOrder, true, true>(L, g_, S_, Eobj); } while (0)

#define RUN_GEMM_MIX(EPI, Aptr, Btptr, K_, Eobj) do { pg8::Gemm g_{(const bf16_t*)(Aptr), (const bf16_t*)(Btptr), MROWS, DM, (K_)}; MixOrder S_; S_.init((int)gridDim.x, (int)blockIdx.x, (K_)); \
    pg8::gemm_phase<EPI, MixOrder, true, true>(L, g_, S_, Eobj); } while (0)

__global__ void __launch_bounds__(NTHR, 2) mk_fwd(Args a_unused) {
    extern __shared__ __attribute__((aligned(16))) unsigned char lds_raw[];
    cg::grid_group grid = cg::this_grid();
    LAS unsigned char* L = (LAS unsigned char*)lds_raw;
    const int NGW = gridDim.x * NWAVES, NGT = gridDim.x * NTHR;
#define FRESH_ARGS ArgP ap = (ArgP)__builtin_amdgcn_kernarg_segment_ptr(); asm volatile("" : "+s"(ap)); unsigned char* ws = ap->ws; (void)ws;
#define FRESH_IDS FRESH_ARGS int tid_ = threadIdx.x; asm volatile("" : "+v"(tid_)); const int tid = tid_, lane = tid & 63, wave = __builtin_amdgcn_readfirstlane(tid >> 6); \
    const int gw = blockIdx.x * NWAVES + wave, gt = blockIdx.x * NTHR + tid; (void)gw; (void)gt; (void)lane;

#ifndef SKIP_PRO
    { FRESH_IDS prologue(ap, L, gw, NGW, wave, lane); }
#endif
    grid.sync();

#pragma unroll 1
    for (int layer = 0; layer < 4; ++layer) {
        const int il = layer >> 1;
        if ((layer & 1) == 0) {
#ifndef SKIP_G1E
            { FRESH_ARGS EpiAct<1> E{(bf16_t*)(ws + WS_BIG), NIN}; RUN_GEMM(EpiAct<1>, ws + WS_XB, ws + WS_WIN(il), NIN, DM, E); }
#endif
            grid.sync();
#ifndef SKIP_MIX
            { FRESH_IDS for (int it = blockIdx.x; it < 32 + 512; it += gridDim.x) {
                if (it < 32) mix_sample(ap, L, il, it, tid, wave, lane);
                else mix_prompt(ap, L, il, (it - 32) >> 2, (it - 32) & 3, tid, wave, lane);
            } }
#endif
            grid.sync();
        } else {
#ifndef SKIP_G1O
            { FRESH_ARGS EpiAct<0> E{(bf16_t*)(ws + WS_BIG), NQKV}; RUN_GEMM(EpiAct<0>, ws + WS_XB, ws + WS_WQKV(il), NQKV, DM, E); }
#endif
            grid.sync();
#ifndef SKIP_ATT
            { FRESH_IDS att_phase(ap, L, il, gw, NGW, wave, lane); }
#endif
            grid.sync();
#ifndef SKIP_MRG
            { FRESH_IDS merge_phase(ap, il, gt, NGT); }
#endif
            grid.sync();
        }
#ifndef SKIP_G2
        { FRESH_ARGS EpiRes E{(float*)(ws + WS_XF)}; const bool ev = (layer & 1) == 0;
          RUN_GEMM_MIX(EpiRes, ws + WS_AB, ws + (ev ? WS_WOUT(il) : WS_WOC(il)), ev ? DM : CW, E); }
#endif
        grid.sync();
        { FRESH_IDS ln_phase(ws, ap->in[15] + layer * DM, ap->in[16] + layer * DM, nullptr, gw, NGW, lane); }
        grid.sync();
#ifndef SKIP_G3
        { FRESH_ARGS EpiAct<2> E{(bf16_t*)(ws + WS_BIG), DFF}; RUN_GEMM(EpiAct<2>, ws + WS_XB, ws + WS_WUP(layer), DFF, DM, E); }
#endif
        grid.sync();
#ifndef SKIP_G4
        { FRESH_ARGS EpiRes E{(float*)(ws + WS_XF)}; RUN_GEMM_MIX(EpiRes, ws + WS_BIG, ws + WS_WDN(layer), DFF, E); }
#endif
        grid.sync();
        { FRESH_IDS ln_phase(ws, ap->in[17] + layer * DM, ap->in[18] + layer * DM, layer == 3 ? ap->out + O_Y : nullptr, gw, NGW, lane); }
        if (layer < 3) grid.sync();
    }
}

extern "C" void kernel_launch(void* const* d_in, const int* in_sizes, int n_in, void* d_out, int out_size, void* d_ws, size_t ws_size, hipStream_t stream) {
    static int grid = 0;
    if (grid == 0) {
        if (n_in != 21 || (size_t)out_size != O_END || ws_size < WS_END) { fprintf(stderr, "kernel_launch: unexpected shapes n_in %d out %d ws %zu\n", n_in, out_size, ws_size); grid = -1; return; }
        int dev = 0, cus = 0, per_cu = 0;
        hipGetDevice(&dev); hipDeviceGetAttribute(&cus, hipDeviceAttributeMultiprocessorCount, dev);
        if (hipFuncSetAttribute((const void*)mk_fwd, hipFuncAttributeMaxDynamicSharedMemorySize, LDS_BYTES) != hipSuccess) fprintf(stderr, "kernel_launch: hipFuncSetAttribute failed\n");
        if (hipOccupancyMaxActiveBlocksPerMultiprocessor(&per_cu, (const void*)mk_fwd, NTHR, LDS_BYTES) != hipSuccess || per_cu < 1) { fprintf(stderr, "kernel_launch: occupancy query says %d\n", per_cu); per_cu = 1; }
        (void)hipGetLastError();
        grid = cus * per_cu;
    }
    if (grid < 0) return;
    Args ha{};
    for (int i = 0; i < 21; ++i) ha.in[i] = (const float*)d_in[i];
    ha.out = (float*)d_out; ha.ws = (unsigned char*)d_ws;
    void* args[] = {&ha};
    hipError_t e = hipLaunchCooperativeKernel((const void*)mk_fwd, dim3(grid), dim3(NTHR), args, LDS_BYTES, stream);
    if (e != hipSuccess) fprintf(stderr, "kernel_launch: cooperative launch failed: %s (grid %d)\n", hipGetErrorString(e), grid);
}
```

```cpp
#include <hip/hip_runtime.h>
#include <hip/hip_cooperative_groups.h>
#include <cstdio>
#include <cstdint>
namespace cg = cooperative_groups;
namespace pg8 {
#define PG8_LAS __attribute__((address_space(3)))
typedef unsigned short bf16_t;
typedef short bf16x8 __attribute__((ext_vector_type(8)));
typedef float f32x4 __attribute__((ext_vector_type(4)));
typedef unsigned u32x4 __attribute__((ext_vector_type(4)));
constexpr int BM = 256, BK = 64, HALF = 128, HTB = HALF * BK * 2  , STAGE_BYTES = 8 * HTB, NXCD = 8, WGM = 8;

__host__ __device__ __forceinline__ int lds_byte(int r, int c) { const int st = (r >> 4) * 2 + (c >> 5), rr = r & 15, cc = c & 31, ob = rr * 64 + cc * 2; return st * 1024 + (ob ^ (((ob >> 9) & 1) << 5)); }
__host__ __device__ __forceinline__ void stage_rc(int b, int& R, int& C) { const int st = b / 1024, sb = b % 1024, swz = sb ^ (((sb >> 9) & 1) << 5); R = (st >> 1) * 16 + swz / 64; C = (st & 1) * 32 + (swz % 64) / 2; }
__host__ __device__ __forceinline__ int perm32(int rho) { const int n = rho >> 4, i = rho & 15; return 8 * (i >> 2) + 4 * n + (i & 3); }

struct Unit { int pm, pn, k0, nt; };
struct Gemm { const bf16_t* A; const bf16_t* Bt; int M, N, K; };

struct StaticOrder {
    int nM, nN, nwg, G, c, KT;
    __host__ __device__ void init(int M, int N, int G_, int c_, int K_) { nM = M / BM; nN = N / BM; nwg = nM * nN; G = G_; c = c_; KT = K_ / BK; }
    __host__ __device__ bool next(int i, Unit& u) const {
        const long L = (long)i * G + c; if (L >= nwg) return false;
        int wgid = (int)L; { const int q = nwg / NXCD, r = nwg % NXCD, xcd = wgid % NXCD, off = wgid / NXCD; wgid = (xcd < r ? xcd * (q + 1) : r * (q + 1) + (xcd - r) * q) + off; }
        const int nig = WGM * nN, gid = wgid / nig, fm = gid * WGM, gsz = (nM - fm) < WGM ? (nM - fm) : WGM;
        u.pm = fm + ((wgid % nig) % gsz); u.pn = (wgid % nig) / gsz; u.k0 = 0; u.nt = KT; return true;
    }
    __device__ __forceinline__ void a_ready(const Unit&) const {}
    __device__ __forceinline__ void done(const Unit&) const {}
};
__device__ __forceinline__ unsigned cvt_pk_bf16(float lo, float hi) { unsigned r; asm volatile("v_cvt_pk_bf16_f32 %0, %1, %2" : "=v"(r) : "v"(lo), "v"(hi)); return r; }
template <class Epi, class Sched, bool ALIGN_EPI = false, bool SP2 = false>
__device__ __forceinline__ void gemm_phase(PG8_LAS unsigned char* lds, const Gemm g, const Sched& S, const Epi& E) {
    int tid_ = threadIdx.x; asm volatile("" : "+v"(tid_)); const int tid = tid_, wid = __builtin_amdgcn_readfirstlane(tid >> 6), lane = tid & 63, wr = wid >> 2, wc = wid & 3, fr = lane & 15, fq = lane >> 4;
    const int K = g.K;
    unsigned voffA[2], voffB[2];
#pragma unroll
    for (int i = 0; i < 2; ++i) { int R, C; stage_rc(tid * 16 + i * 8192, R, C); const int Rb = Epi::PERM ? ((R & ~31) + perm32(R & 31)) : R;
        voffA[i] = (unsigned)(R * K + C) * 2u; voffB[i] = (unsigned)(Rb * K + C) * 2u; }
    const size_t kstep = (size_t)(BK * 2);
    const size_t hstep = (size_t)HALF * K * 2;
    const size_t tstep = 2 * hstep;
    const unsigned ldsw = (unsigned)wid * 1024u;
    const int aoff = lds_byte(wr * 64 + fr, fq * 8), boff = lds_byte(wc * 32 + fr, fq * 8);
#define PG8_SA(b, h) (((b) * 2 + (h)) * HTB)
#define PG8_SB(b, h) ((4 + (b) * 2 + (h)) * HTB)
#define PG8_STAGE(bufoff, gbase, voff) do { _Pragma("unroll") for (int _i = 0; _i < 2; ++_i) \
        __builtin_amdgcn_global_load_lds((const unsigned*)((const char*)(gbase) + (voff)[_i]), (PG8_LAS unsigned*)(lds + (bufoff) + ldsw + _i * 8192), 16, 0, 0); } while (0)
#define PG8_LDA(dst, b, h) do { _Pragma("unroll") for (int m = 0; m < 4; ++m) _Pragma("unroll") for (int k = 0; k < 2; ++k) dst[m][k] = *(const PG8_LAS bf16x8*)(lds + PG8_SA(b, h) + aoff + m * 2048 + k * 1024); } while (0)
#define PG8_LDB(dst, b, h) do { _Pragma("unroll") for (int n = 0; n < 2; ++n) _Pragma("unroll") for (int k = 0; k < 2; ++k) dst[n][k] = *(const PG8_LAS bf16x8*)(lds + PG8_SB(b, h) + boff + n * 2048 + k * 1024); } while (0)
#define PG8_MMA(ai, bj, At, Bt) do { __builtin_amdgcn_s_setprio(1); _Pragma("unroll") for (int m = 0; m < 4; ++m) _Pragma("unroll") for (int n = 0; n < 2; ++n) _Pragma("unroll") for (int k = 0; k < 2; ++k) \
        acc[ai][bj][m][n] = __builtin_amdgcn_mfma_f32_16x16x32_bf16(Bt[n][k], At[m][k], acc[ai][bj][m][n], 0, 0, 0); __builtin_amdgcn_s_setprio(0); } while (0)
#define PG8_WAIT_V(n) asm volatile("s_waitcnt vmcnt(" #n ")" ::: "memory")
#define PG8_WAIT_L(n) asm volatile("s_waitcnt lgkmcnt(" #n ")" ::: "memory")
#define PG8_BAR __builtin_amdgcn_s_barrier()
#define PG8_SCHED __builtin_amdgcn_sched_barrier(0)
    Unit cur, nxt; int ui = 0;
    if (!S.next(0, cur)) return;
    f32x4 acc[2][2][4][2];
#pragma unroll
    for (int a = 0; a < 2; ++a)
#pragma unroll
        for (int b = 0; b < 2; ++b)
#pragma unroll
            for (int m = 0; m < 4; ++m)
#pragma unroll
                for (int n = 0; n < 2; ++n) acc[a][b][m][n] = (f32x4){0.f, 0.f, 0.f, 0.f};
    bf16x8 At[4][2], B0[2][2], B1[2][2];
    const char* cA = (const char*)g.A + (size_t)cur.pm * tstep + (size_t)cur.k0 * 2; const char* cB = (const char*)g.Bt + (size_t)cur.pn * tstep + (size_t)cur.k0 * 2;
    S.a_ready(cur);
    if constexpr (SP2) {
        PG8_STAGE(PG8_SB(0, 0), cB, voffB); PG8_STAGE(PG8_SB(0, 1), cB + hstep, voffB); PG8_STAGE(PG8_SA(0, 0), cA, voffA); PG8_STAGE(PG8_SA(0, 1), cA + hstep, voffA);
        if (wr == 1) PG8_BAR;
        PG8_WAIT_V(2); PG8_BAR;
        PG8_STAGE(PG8_SB(1, 0), cB + kstep, voffB); PG8_STAGE(PG8_SA(1, 0), cA + kstep, voffA); PG8_STAGE(PG8_SB(1, 1), cB + hstep + kstep, voffB);
        PG8_WAIT_V(6); PG8_BAR;
    } else {
        PG8_STAGE(PG8_SB(0, 0), cB, voffB); PG8_STAGE(PG8_SA(0, 0), cA, voffA); PG8_STAGE(PG8_SB(0, 1), cB + hstep, voffB); PG8_STAGE(PG8_SA(0, 1), cA + hstep, voffA);
        if (wr == 1) PG8_BAR;
        PG8_WAIT_V(4); PG8_BAR;
        PG8_STAGE(PG8_SB(1, 0), cB + kstep, voffB); PG8_STAGE(PG8_SA(1, 0), cA + kstep, voffA); PG8_STAGE(PG8_SB(1, 1), cB + hstep + kstep, voffB);
        PG8_WAIT_V(6); PG8_BAR;
    }
    for (;;) {
        const bool has_next = S.next(ui + 1, nxt);
        const char* nA = has_next ? (const char*)g.A + (size_t)nxt.pm * tstep + (size_t)nxt.k0 * 2 : cA; const char* nB = has_next ? (const char*)g.Bt + (size_t)nxt.pn * tstep + (size_t)nxt.k0 * 2 : cB;
        const int nt = cur.nt;
        for (int t = 0; t < nt; t += 2) {
            const bool last = (t == nt - 2);
            const char* a1 = cA + (size_t)(t + 1) * kstep;
            const char* a2 = last ? nA : cA + (size_t)(t + 2) * kstep; const char* b2 = last ? nB : cB + (size_t)(t + 2) * kstep;
            const char* a3 = a2 + kstep; const char* b3 = b2 + kstep;
            if (last && has_next) S.a_ready(nxt);
            if constexpr (SP2) {
            PG8_LDB(B0, 0, 0); PG8_LDB(B1, 0, 1); PG8_SCHED; PG8_LDA(At, 0, 0); PG8_STAGE(PG8_SA(1, 1), a1 + hstep, voffA);
            PG8_WAIT_V(8); PG8_WAIT_L(0); PG8_BAR; PG8_MMA(0, 0, At, B0); PG8_MMA(0, 1, At, B1); PG8_BAR; PG8_SCHED;
            PG8_LDA(At, 0, 1); PG8_STAGE(PG8_SB(0, 0), b2, voffB); PG8_STAGE(PG8_SB(0, 1), b2 + hstep, voffB); PG8_STAGE(PG8_SA(0, 0), a2, voffA);
            PG8_WAIT_V(8); PG8_WAIT_L(0); PG8_BAR; PG8_MMA(1, 0, At, B0); PG8_MMA(1, 1, At, B1); PG8_BAR; PG8_SCHED;
            PG8_LDB(B0, 1, 0); PG8_LDB(B1, 1, 1); PG8_SCHED; PG8_LDA(At, 1, 0); PG8_STAGE(PG8_SA(0, 1), a2 + hstep, voffA);
            PG8_WAIT_V(8); PG8_WAIT_L(0); PG8_BAR; PG8_MMA(0, 0, At, B0); PG8_MMA(0, 1, At, B1); PG8_BAR; PG8_SCHED;
            PG8_LDA(At, 1, 1); PG8_STAGE(PG8_SB(1, 0), b3, voffB); PG8_STAGE(PG8_SB(1, 1), b3 + hstep, voffB); PG8_STAGE(PG8_SA(1, 0), a3, voffA);
            PG8_WAIT_V(8); PG8_WAIT_L(0); PG8_BAR; PG8_MMA(1, 0, At, B0); PG8_MMA(1, 1, At, B1); PG8_BAR; PG8_SCHED;
            } else {
            PG8_LDB(B0, 0, 0); PG8_SCHED; PG8_LDA(At, 0, 0); PG8_STAGE(PG8_SA(1, 1), a1 + hstep, voffA);
            PG8_WAIT_L(8); PG8_BAR; PG8_WAIT_L(0); PG8_MMA(0, 0, At, B0); PG8_BAR; PG8_SCHED;
            PG8_LDB(B1, 0, 1); PG8_STAGE(PG8_SB(0, 0), b2, voffB);
            PG8_BAR; PG8_WAIT_L(0); PG8_MMA(0, 1, At, B1); PG8_BAR;
            PG8_LDA(At, 0, 1); PG8_STAGE(PG8_SA(0, 0), a2, voffA);
            PG8_BAR; PG8_WAIT_L(0); PG8_MMA(1, 0, At, B0); PG8_BAR; PG8_SCHED;
            PG8_STAGE(PG8_SB(0, 1), b2 + hstep, voffB);
            PG8_WAIT_V(6); PG8_BAR; PG8_MMA(1, 1, At, B1); PG8_BAR;
            PG8_LDB(B0, 1, 0); PG8_SCHED; PG8_LDA(At, 1, 0); PG8_STAGE(PG8_SA(0, 1), a2 + hstep, voffA);
            PG8_WAIT_L(8); PG8_BAR; PG8_WAIT_L(0); PG8_MMA(0, 0, At, B0); PG8_BAR; PG8_SCHED;
            PG8_LDB(B1, 1, 1); PG8_STAGE(PG8_SB(1, 0), b3, voffB);
            PG8_BAR; PG8_WAIT_L(0); PG8_MMA(0, 1, At, B1); PG8_BAR;
            PG8_LDA(At, 1, 1); PG8_STAGE(PG8_SA(1, 0), a3, voffA);
            PG8_BAR; PG8_WAIT_L(0); PG8_MMA(1, 0, At, B0); PG8_BAR; PG8_SCHED;
            PG8_STAGE(PG8_SB(1, 1), b3 + hstep, voffB);
            PG8_WAIT_V(6); PG8_BAR; PG8_MMA(1, 1, At, B1); PG8_BAR;
            }
        }
        if constexpr (ALIGN_EPI) { if (wr == 0) PG8_BAR; }
        if constexpr (!Epi::AFTER_DRAIN) { E(acc, cur, wr, wc, fr, fq); S.done(cur); }
        if (!has_next) break;
#pragma unroll
        for (int a = 0; a < 2; ++a)
#pragma unroll
            for (int b = 0; b < 2; ++b)
#pragma unroll
                for (int m = 0; m < 4; ++m)
#pragma unroll
                    for (int n = 0; n < 2; ++n) acc[a][b][m][n] = (f32x4){0.f, 0.f, 0.f, 0.f};
        cur = nxt; cA = nA; cB = nB; ++ui;
        if constexpr (ALIGN_EPI) { if (wr == 1) PG8_BAR; }
    }
    PG8_WAIT_V(0);
    if constexpr (!ALIGN_EPI) { if (wr == 0) PG8_BAR; }
    PG8_BAR;
    if constexpr (Epi::AFTER_DRAIN) { E.fused(acc, cur, wr, wc, fr, fq, lds, wid, lane); S.done(cur); }
#undef PG8_SA
#undef PG8_SB
#undef PG8_STAGE
#undef PG8_LDA
#undef PG8_LDB
#undef PG8_MMA
#undef PG8_WAIT_V
#undef PG8_WAIT_L
#undef PG8_BAR
#undef PG8_SCHED
}
}

#define LAS __attribute__((address_space(3)))
typedef unsigned short bf16_t;
typedef short bf16x8 __attribute__((ext_vector_type(8)));
typedef float f32x4 __attribute__((ext_vector_type(4)));
typedef float f32x2 __attribute__((ext_vector_type(2)));
typedef float f32x16 __attribute__((ext_vector_type(16)));
typedef unsigned u32x4 __attribute__((ext_vector_type(4)));
typedef unsigned u32x2 __attribute__((ext_vector_type(2)));

constexpr int DM = 1024, SEQ = 8192, NB = 2, MP = NB * SEQ, DB = 32, DT = 8, MS = DB * DT, MROWS = MP + MS;
constexpr int NIN = 2560, NQKV = 4608, DFF = 4096, CW = 512;
constexpr float ALPHA = 1.681792830507429f;
constexpr float LN_EPS = 1e-5f, LOG2E = 1.4426950408889634f;
constexpr int NWAVES = 8, NTHR = 512;
constexpr int LDS_BYTES = 147456, MISC_OFF = 131072 + 320;

constexpr size_t MiB = 1u << 20;
__host__ __device__ constexpr size_t WS_WIN(int i) { return (0 + 5 * (size_t)i) * MiB; }
__host__ __device__ constexpr size_t WS_WOUT(int i) { return (10 + 2 * (size_t)i) * MiB; }
__host__ __device__ constexpr size_t WS_WQKV(int i) { return (14 + 9 * (size_t)i) * MiB; }
__host__ __device__ constexpr size_t WS_WOC(int i) { return (32 + (size_t)i) * MiB; }
__host__ __device__ constexpr size_t WS_WUP(int l) { return (34 + 8 * (size_t)l) * MiB; }
__host__ __device__ constexpr size_t WS_WDN(int l) { return (66 + 8 * (size_t)l) * MiB; }
constexpr size_t WS_XF = 98 * MiB, WS_XB = 163 * MiB, WS_AB = 196 * MiB, WS_BIG = 229 * MiB, WS_OG = 376 * MiB, WS_LSE = 425 * MiB, WS_PART = 427 * MiB, WS_CTL = 443 * MiB, WS_END = 444 * MiB;
static_assert((size_t)MROWS * DM * 4 == 65 * MiB, "XF size");

constexpr size_t O_Y = 0, O_CONVP = 17039360, O_CONVS = O_CONVP + 4096, O_CHV = O_CONVS + 65536, O_KVP0 = O_CHV + 262144, O_KVP1 = O_KVP0 + 524288,
                 O_KVP2 = O_KVP1 + 2097152, O_KVS0 = O_KVP2 + 8388608, O_KVS1 = O_KVS0 + 8388608, O_KVS2 = O_KVS1 + 33554432, O_END = O_KVS2 + 134217728;
static_assert(O_END == 204541952, "out size");

struct Args { const float* in[21]; float* out; unsigned char* ws; int pad0, pad1; };
typedef const __attribute__((address_space(4))) Args* ArgP;

__device__ __forceinline__ float bf2f(unsigned short b) { return __uint_as_float((unsigned)b << 16); }
__device__ __forceinline__ unsigned pk2(float lo, float hi) { return pg8::cvt_pk_bf16(lo, hi); }
__device__ __forceinline__ float wave_sum(float v) {
#pragma unroll
    for (int o = 1; o < 64; o <<= 1) v += __shfl_xor(v, o);
    return v;
}
__device__ __forceinline__ void unpack8(const u32x4 w, float* f) {
    f[0] = __uint_as_float(w.x << 16); f[1] = __uint_as_float(w.x & 0xffff0000u); f[2] = __uint_as_float(w.y << 16); f[3] = __uint_as_float(w.y & 0xffff0000u);
    f[4] = __uint_as_float(w.z << 16); f[5] = __uint_as_float(w.z & 0xffff0000u); f[6] = __uint_as_float(w.w << 16); f[7] = __uint_as_float(w.w & 0xffff0000u);
}
#define WAVE_LDS_FENCE() do { asm volatile("s_waitcnt lgkmcnt(0)" ::: "memory"); __builtin_amdgcn_wave_barrier(); } while (0)

__device__ __forceinline__ float gelu_tanh(float x) {
    const float u = x * (0.7978845608028654f + 0.035677408136300125f * x * x);
    const float e = __builtin_amdgcn_exp2f(-2.0f * LOG2E * u);
    return x * __builtin_amdgcn_rcpf(1.0f + e);
}
template <int ACT  > struct EpiAct {
    static constexpr bool PERM = true, AFTER_DRAIN = false;
    bf16_t* O; int ldc;
    __device__ __forceinline__ void operator()(const pg8::f32x4 (&acc)[2][2][4][2], const pg8::Unit& u, int wr, int wc, int fr, int fq) const {
        const int row0 = u.pm * 256 + wr * 64 + fr, col0 = u.pn * 256 + wc * 32 + 8 * fq;
        const bool dog = (ACT == 1) && (u.pn < 4);
#pragma unroll
        for (int ai = 0; ai < 2; ++ai)
#pragma unroll
            for (int m = 0; m < 4; ++m) { bf16_t* rowp = O + (size_t)(row0 + ai * 128 + m * 16) * ldc + col0;
#pragma unroll
                for (int bj = 0; bj < 2; ++bj) { pg8::f32x4 v0 = acc[ai][bj][m][0], v1 = acc[ai][bj][m][1];
                    if (ACT == 1) { if (dog) {
#pragma unroll
                        for (int e = 0; e < 4; ++e) { v0[e] = gelu_tanh(v0[e]); v1[e] = gelu_tanh(v1[e]); } } }
                    if (ACT == 2) {
#pragma unroll
                        for (int e = 0; e < 4; ++e) { const float a = fmaxf(v0[e], 0.f), b = fmaxf(v1[e], 0.f); v0[e] = a * a; v1[e] = b * b; } }
                    u32x4 w; w.x = pk2(v0[0], v0[1]); w.y = pk2(v0[2], v0[3]); w.z = pk2(v1[0], v1[1]); w.w = pk2(v1[2], v1[3]);
                    *(u32x4*)(rowp + bj * 128) = w; } asm volatile("" ::: "memory"); }
    }
};
struct EpiRes {
    static constexpr bool PERM = true, AFTER_DRAIN = false;
    float* XF; float* PART;
    __device__ __forceinline__ void operator()(const pg8::f32x4 (&acc)[2][2][4][2], const pg8::Unit& u, int wr, int wc, int fr, int fq) const {
        const int row0 = u.pm * 256 + wr * 64 + fr, col0 = u.pn * 256 + wc * 32 + 8 * fq;
        if (u.pm == 64) {
            float* P = PART + (size_t)(u.k0 >> 8) * (MS * DM);
#pragma unroll
            for (int ai = 0; ai < 2; ++ai)
#pragma unroll
                for (int m = 0; m < 4; ++m) { float* rowp = P + (size_t)(wr * 64 + fr + ai * 128 + m * 16) * DM + col0;
#pragma unroll
                    for (int bj = 0; bj < 2; ++bj) { *(f32x4*)(rowp + bj * 128) = acc[ai][bj][m][0]; *(f32x4*)(rowp + bj * 128 + 4) = acc[ai][bj][m][1]; } }
            return;
        }
#pragma unroll
        for (int ai = 0; ai < 2; ++ai)
#pragma unroll
            for (int m = 0; m < 4; ++m) { float* rowp = XF + (size_t)(row0 + ai * 128 + m * 16) * DM + col0;
#pragma unroll
                for (int bj = 0; bj < 2; ++bj) { f32x4* p = (f32x4*)(rowp + bj * 128);
                    f32x4 a = p[0], b = p[1];
#pragma unroll
                    for (int e = 0; e < 4; ++e) { a[e] = ALPHA * a[e] + acc[ai][bj][m][0][e]; b[e] = ALPHA * b[e] + acc[ai][bj][m][1][e]; }
                    p[0] = a; p[1] = b; asm volatile("" ::: "memory"); } }
    }
};

struct MixOrder {
    int G, c, KT, npieces; pg8::StaticOrder P;
    __device__ void init(int G_, int c_, int K_) { G = G_; c = c_; KT = K_ / 64; npieces = 4 * (K_ / 256); P.init(MP, DM, 1, 0, K_); }
    __device__ bool next(int i, pg8::Unit& u) const {
        const int Lx = i * G + c;
        if (Lx < npieces) { u.pm = 64; u.pn = Lx & 3; u.k0 = (Lx >> 2) * 256; u.nt = 4; return true; }
        return P.next(Lx - npieces, u);
    }
    __device__ __forceinline__ void a_ready(const pg8::Unit&) const {}
    __device__ __forceinline__ void done(const pg8::Unit&) const {}
};


constexpr int NCHUNK = 5376, HOST_CNT = 3;
constexpr int HOSTED = 2 * (118 + 110) * HOST_CNT + 4 * 240 * HOST_CNT, COPY_PRO = NCHUNK - HOSTED;
static_assert(COPY_PRO > 0, "copy split");
__device__ __forceinline__ void copy_chunk(ArgP ap, int cid, int tid) {
    const int g = cid < 256 ? 0 : cid < 1280 ? 1 : 2, lc = cid - (g == 0 ? 0 : g == 1 ? 256 : 1280), L = 128 << (2 * g);
    const unsigned blk4 = (unsigned)L * 256u, keep4 = (unsigned)(L - 8) * 256u;
    const f32x4* src = (const f32x4*)ap->in[3 + g] + (size_t)lc * 8192; f32x4* dst = (f32x4*)(ap->out + (g == 0 ? O_KVS0 : g == 1 ? O_KVS1 : O_KVS2)) + (size_t)lc * 8192;
    const unsigned ub = (unsigned)lc * 8192u;
#pragma unroll 1
    for (int h = 0; h < 2; ++h) {
        f32x4 v[8]; bool ok[8];
#pragma unroll
        for (int k = 0; k < 8; ++k) { const unsigned u = (unsigned)(h * 4096 + k * 512 + tid); ok[k] = (((ub + u) & (blk4 - 1u)) < keep4);
            if (ok[k]) v[k] = __builtin_nontemporal_load(src + u + 8 * 256); }
#pragma unroll
        for (int k = 0; k < 8; ++k) { const unsigned u = (unsigned)(h * 4096 + k * 512 + tid); if (ok[k]) __builtin_nontemporal_store(v[k], dst + u); }
    }
}
__device__ __forceinline__ void host_copy(ArgP ap, int first, int rank, int nrank, int tid) {
#pragma unroll 1
    for (int j = 0; j < HOST_CNT; ++j) { const int cid = first + rank + j * nrank; if (cid < NCHUNK) copy_chunk(ap, cid, tid); }
}

__device__ __forceinline__ void p0_transpose_item(const float* W, int K, int N, bf16_t* WT, LAS float* scr, int item, int lane) {
    const int nblk = N / 32, kb = item / nblk, nb = item % nblk, k0 = 64 * kb, n0 = 32 * nb;
#pragma unroll
    for (int i = 0; i < 32; ++i) { const int kk = 2 * i + (lane >> 5); scr[kk * 33 + (lane & 31)] = W[(size_t)(k0 + kk) * N + n0 + (lane & 31)]; }
    asm volatile("s_waitcnt lgkmcnt(0)" ::: "memory");
    const int c = lane & 7;
#pragma unroll
    for (int j = 0; j < 4; ++j) { const int n = (lane >> 3) + 8 * j; const LAS float* s = scr + (8 * c) * 33 + n;
        u32x4 o; o.x = pk2(s[0 * 33], s[1 * 33]); o.y = pk2(s[2 * 33], s[3 * 33]); o.z = pk2(s[4 * 33], s[5 * 33]); o.w = pk2(s[6 * 33], s[7 * 33]);
        *(u32x4*)(WT + (size_t)(n0 + n) * K + k0 + 8 * c) = o; }
    asm volatile("s_waitcnt lgkmcnt(0)" ::: "memory");
}

__device__ __forceinline__ void prologue(ArgP ap, LAS unsigned char* lds, int gw, int NGW, int wave, int lane) {
    LAS float* scr = (LAS float*)(lds + wave * 16384);
    unsigned char* ws = ap->ws;
#pragma unroll 1
    for (int mt = 0; mt < 16; ++mt) {
        const float* src; bf16_t* dst; int K, N;
        if (mt < 8) { const int i = mt & 1, k = mt >> 1;
            if (k == 0) { src = ap->in[6] + (size_t)i * DM * NIN; dst = (bf16_t*)(ws + WS_WIN(i)); K = DM; N = NIN; }
            else if (k == 1) { src = ap->in[12] + (size_t)i * DM * DM; dst = (bf16_t*)(ws + WS_WOUT(i)); K = DM; N = DM; }
            else if (k == 2) { src = ap->in[13] + (size_t)i * DM * NQKV; dst = (bf16_t*)(ws + WS_WQKV(i)); K = DM; N = NQKV; }
            else { src = ap->in[14] + (size_t)i * CW * DM; dst = (bf16_t*)(ws + WS_WOC(i)); K = CW; N = DM; }
        } else if (mt < 12) { const int l = mt - 8; src = ap->in[19] + (size_t)l * DM * DFF; dst = (bf16_t*)(ws + WS_WUP(l)); K = DM; N = DFF; }
        else { const int l = mt - 12; src = ap->in[20] + (size_t)l * DFF * DM; dst = (bf16_t*)(ws + WS_WDN(l)); K = DFF; N = DM; }
        const int items = (K / 64) * (N / 32);
        for (int it = gw; it < items; it += NGW) p0_transpose_item(src, K, N, dst, scr, it, lane);
    }
    const int gt = gw * 64 + lane, NGT = NGW * 64;
    {
        float* XF = (float*)(ws + WS_XF); bf16_t* XB = (bf16_t*)(ws + WS_XB);
        for (int u0 = gt; u0 < MROWS * 256; u0 += NGT * 4) {
            f32x4 v[4];
#pragma unroll
            for (int k = 0; k < 4; ++k) { const int u = u0 + k * NGT; if (u < MROWS * 256) v[k] = (u < MP * 256) ? ((const f32x4*)ap->in[0])[u] : ((const f32x4*)ap->in[1])[u - MP * 256]; }
#pragma unroll
            for (int k = 0; k < 4; ++k) { const int u = u0 + k * NGT; if (u < MROWS * 256) {
                ((f32x4*)XF)[u] = (u < MP * 256) ? v[k] : v[k] * ALPHA; u32x2 w; w.x = pk2(v[k][0], v[k][1]); w.y = pk2(v[k][2], v[k][3]); ((u32x2*)XB)[u] = w; } }
        }
    }
    for (int cid = blockIdx.x; cid < COPY_PRO; cid += gridDim.x) copy_chunk(ap, cid, lane + 64 * wave);
}

__device__ __forceinline__ void ln_phase(unsigned char* ws, const float* gam, const float* bet, float* outp, int nslice, int gw, int NGW, int lane) {
    float* XF = (float*)(ws + WS_XF); bf16_t* XB = (bf16_t*)(ws + WS_XB); const float* PART = (const float*)(ws + WS_PART);
    f32x4 g4[4], b4[4];
#pragma unroll
    for (int j = 0; j < 4; ++j) { g4[j] = ((const f32x4*)gam)[lane + 64 * j]; b4[j] = ((const f32x4*)bet)[lane + 64 * j]; }
    int row = gw; f32x4 v[4], vn[4];
    if (row < MROWS) {
#pragma unroll
        for (int j = 0; j < 4; ++j) v[j] = ((const f32x4*)(XF + (size_t)row * DM))[lane + 64 * j]; }
    while (row < MROWS) {
        const int nrow = row + NGW;
        if (nrow < MROWS) {
#pragma unroll
            for (int j = 0; j < 4; ++j) vn[j] = ((const f32x4*)(XF + (size_t)nrow * DM))[lane + 64 * j]; }
        if (row >= MP) {
            for (int sidx = 0; sidx < nslice; ++sidx) { const f32x4* pr = (const f32x4*)(PART + ((size_t)sidx * MS + (row - MP)) * DM) + lane;
#pragma unroll
                for (int j = 0; j < 4; ++j) v[j] = v[j] + pr[64 * j]; } }
        float s = 0.f;
#pragma unroll
        for (int j = 0; j < 4; ++j) s += (v[j][0] + v[j][1]) + (v[j][2] + v[j][3]);
        const float mean = wave_sum(s) * (1.f / DM); float s2 = 0.f;
#pragma unroll
        for (int j = 0; j < 4; ++j) { v[j] = v[j] - mean; s2 += (v[j][0] * v[j][0] + v[j][1] * v[j][1]) + (v[j][2] * v[j][2] + v[j][3] * v[j][3]); }
        const float rstd = 1.f / sqrtf(wave_sum(s2) * (1.f / DM) + LN_EPS);
        u32x2* ob = (u32x2*)(XB + (size_t)row * DM) + lane; f32x4* xr = (f32x4*)(XF + (size_t)row * DM) + lane;
#pragma unroll
        for (int j = 0; j < 4; ++j) { f32x4 y = v[j] * rstd * g4[j] + b4[j];
            if (outp) ((f32x4*)(outp + (size_t)row * DM))[lane + 64 * j] = y; else xr[64 * j] = (row >= MP) ? y * ALPHA : y;
            u32x2 w; w.x = pk2(y[0], y[1]); w.y = pk2(y[2], y[3]); ob[64 * j] = w; }
#pragma unroll
        for (int j = 0; j < 4; ++j) v[j] = vn[j];
        row = nrow;
    }
}

__device__ __forceinline__ void mix_prompt(ArgP ap, LAS unsigned char* lds, int il, int chunk, int g, int tid, int wave, int lane) {
    const bf16_t* Z = (const bf16_t*)(ap->ws + WS_BIG); bf16_t* AB = (bf16_t*)(ap->ws + WS_AB);
    const int row0 = chunk * 128;
    LAS f32x2* stats = (LAS f32x2*)lds; LAS unsigned char* vnT = lds + 1024;
    u32x4 zw[16];
#pragma unroll
    for (int k = 0; k < 16; ++k) zw[k] = *(const u32x4*)(Z + (size_t)(row0 + wave * 16 + k) * NIN + 512 + lane * 8);
#pragma unroll
    for (int k = 0; k < 16; ++k) { const int r = wave * 16 + k;
        float f[8]; unpack8(zw[k], f);
        float s = 0.f;
#pragma unroll
        for (int e = 0; e < 8; ++e) s += f[e];
        const float mean = wave_sum(s) * (1.f / 512.f); float q = 0.f;
#pragma unroll
        for (int e = 0; e < 8; ++e) { const float d = f[e] - mean; q += d * d; }
        const float rstd = 1.f / sqrtf(wave_sum(q) * (1.f / 512.f) + LN_EPS);
        if (lane == 0) stats[r] = (f32x2){mean, rstd}; }
    __syncthreads();
    const float* lg = ap->in[7] + il * 512 + g * 128; const float* lb = ap->in[8] + il * 512 + g * 128;
#pragma unroll
    for (int k = 0; k < 2; ++k) { const int id = tid + 512 * k, p = id & 63, cc = id >> 6;
        const u32x4 w0 = *(const u32x4*)(Z + (size_t)(row0 + 2 * p) * NIN + 512 + g * 128 + cc * 8), w1 = *(const u32x4*)(Z + (size_t)(row0 + 2 * p + 1) * NIN + 512 + g * 128 + cc * 8);
        float f0[8], f1[8]; unpack8(w0, f0); unpack8(w1, f1);
        const f32x2 s0 = stats[2 * p], s1 = stats[2 * p + 1];
#pragma unroll
        for (int e = 0; e < 8; ++e) { const float gg = lg[cc * 8 + e], bb = lb[cc * 8 + e];
            const float y0 = (f0[e] - s0.x) * s0.y * gg + bb, y1 = (f1[e] - s1.x) * s1.y * gg + bb;
            *(LAS unsigned*)(vnT + ((cc * 8 + e) * 136 + 2 * p) * 2) = pk2(y0, y1); } }
    __syncthreads();
    {
        const int fr = lane & 15, fq = lane >> 4, i = wave * 16 + fr, nks = (wave >> 1) + 1;
        const float* Wr = ap->in[9] + ((size_t)(il * 4 + g) * 128 + i) * 128;
        pg8::f32x4 acc[8];
#pragma unroll
        for (int nt = 0; nt < 8; ++nt) acc[nt] = (pg8::f32x4){0.f, 0.f, 0.f, 0.f};
        for (int ks = 0; ks < nks; ++ks) { const int j0 = 32 * ks + 8 * fq;
            const f32x4 wa = *(const f32x4*)(Wr + j0), wb = *(const f32x4*)(Wr + j0 + 4);
            float wf[8] = {wa[0], wa[1], wa[2], wa[3], wb[0], wb[1], wb[2], wb[3]};
#pragma unroll
            for (int e = 0; e < 8; ++e) wf[e] = (j0 + e <= i) ? wf[e] : 0.f;
            u32x4 aw; aw.x = pk2(wf[0], wf[1]); aw.y = pk2(wf[2], wf[3]); aw.z = pk2(wf[4], wf[5]); aw.w = pk2(wf[6], wf[7]);
            const bf16x8 af = __builtin_bit_cast(bf16x8, aw);
#pragma unroll
            for (int nt = 0; nt < 8; ++nt) { const bf16x8 bfr = *(const LAS bf16x8*)(vnT + ((16 * nt + fr) * 136 + 32 * ks + 8 * fq) * 2);
                acc[nt] = __builtin_amdgcn_mfma_f32_16x16x32_bf16(bfr, af, acc[nt], 0, 0, 0); } }
        const float bs = ap->in[10][(il * 4 + g) * 128 + i];
        const bf16_t* up = Z + (size_t)(row0 + i) * NIN + g * 128 + 4 * fq; bf16_t* op = AB + (size_t)(row0 + i) * DM + g * 128 + 4 * fq;
#pragma unroll
        for (int nt = 0; nt < 8; ++nt) { const u32x2 uw = *(const u32x2*)(up + 16 * nt);
            const float u0 = __uint_as_float(uw.x << 16), u1 = __uint_as_float(uw.x & 0xffff0000u), u2 = __uint_as_float(uw.y << 16), u3 = __uint_as_float(uw.y & 0xffff0000u);
            u32x2 o; o.x = pk2(u0 * (acc[nt][0] + bs), u1 * (acc[nt][1] + bs)); o.y = pk2(u2 * (acc[nt][2] + bs), u3 * (acc[nt][3] + bs));
            *(u32x2*)(op + 16 * nt) = o; }
    }
    {
        const float* cw = ap->in[11] + (size_t)il * 3 * 512;
#pragma unroll 1
        for (int k = 0; k < 4; ++k) { const int id = tid + 512 * k, cc = id & 15, r = id >> 4, c0 = g * 128 + cc * 8, row = row0 + r, t = row & (SEQ - 1);
            const bf16_t* zr = Z + (size_t)row * NIN + c0;
            float ch0[8], ch1[8], ch2[8], bg[8], x[8], y[8];
            unpack8(*(const u32x4*)(zr + 1536), x); unpack8(*(const u32x4*)(zr + 2048), y);
#pragma unroll
            for (int e = 0; e < 8; ++e) ch2[e] = x[e] * y[e];
            if (t >= 1) { unpack8(*(const u32x4*)(zr - NIN + 1536), x); unpack8(*(const u32x4*)(zr - NIN + 2048), y);
#pragma unroll
                for (int e = 0; e < 8; ++e) ch1[e] = x[e] * y[e]; } else {
#pragma unroll
                for (int e = 0; e < 8; ++e) ch1[e] = 0.f; }
            if (t >= 2) { unpack8(*(const u32x4*)(zr - 2 * NIN + 1536), x); unpack8(*(const u32x4*)(zr - 2 * NIN + 2048), y);
#pragma unroll
                for (int e = 0; e < 8; ++e) ch0[e] = x[e] * y[e]; } else {
#pragma unroll
                for (int e = 0; e < 8; ++e) ch0[e] = 0.f; }
            unpack8(*(const u32x4*)(zr + 1024), bg);
            float o[8];
#pragma unroll
            for (int e = 0; e < 8; ++e) o[e] = bg[e] * (cw[c0 + e] * ch0[e] + cw[512 + c0 + e] * ch1[e] + cw[1024 + c0 + e] * ch2[e]);
            u32x4 w; w.x = pk2(o[0], o[1]); w.y = pk2(o[2], o[3]); w.z = pk2(o[4], o[5]); w.w = pk2(o[6], o[7]);
            *(u32x4*)(AB + (size_t)row * DM + 512 + c0) = w;
            if (t >= SEQ - 2) { float* cp = ap->out + O_CONVP + ((size_t)(il * 2 + (row >> 13)) * 2 + (t - (SEQ - 2))) * 512 + c0;
                *(f32x4*)cp = (f32x4){ch2[0], ch2[1], ch2[2], ch2[3]}; *(f32x4*)(cp + 4) = (f32x4){ch2[4], ch2[5], ch2[6], ch2[7]}; } }
    }
    __syncthreads();
}

__device__ __forceinline__ void mix_sample(ArgP ap, LAS unsigned char* lds, int il, int db, int tid, int wave, int lane) {
    const bf16_t* Z = (const bf16_t*)(ap->ws + WS_BIG); bf16_t* AB = (bf16_t*)(ap->ws + WS_AB);
    const int R0 = MP + db * 8;
    LAS float* vnS = (LAS float*)lds;
    {
        const u32x4 w = *(const u32x4*)(Z + (size_t)(R0 + wave) * NIN + 512 + lane * 8); float f[8]; unpack8(w, f);
        float s = 0.f;
#pragma unroll
        for (int e = 0; e < 8; ++e) s += f[e];
        const float mean = wave_sum(s) * (1.f / 512.f); float q = 0.f;
#pragma unroll
        for (int e = 0; e < 8; ++e) { const float d = f[e] - mean; q += d * d; }
        const float rstd = 1.f / sqrtf(wave_sum(q) * (1.f / 512.f) + LN_EPS);
        float* cv = ap->out + O_CHV + ((size_t)(il * DB + db) * 8 + wave) * 512 + lane * 8;
#pragma unroll
        for (int e = 0; e < 8; ++e) { const float y = (f[e] - mean) * rstd * ap->in[7][il * 512 + lane * 8 + e] + ap->in[8][il * 512 + lane * 8 + e]; vnS[wave * 512 + lane * 8 + e] = y; cv[e] = y; }
    }
    __syncthreads();
    {
        const int c = tid, g = c >> 7;
        const float* Wg = ap->in[9] + (size_t)(il * 4 + g) * 128 * 128;
        float vv[8];
#pragma unroll
        for (int j = 0; j < 8; ++j) vv[j] = vnS[j * 512 + c];
#pragma unroll
        for (int i = 0; i < 8; ++i) { float y = ap->in[10][(il * 4 + g) * 128 + i];
#pragma unroll
            for (int j = 0; j < 8; ++j) if (j <= i) y += Wg[i * 128 + j] * vv[j];
            const float u = bf2f(Z[(size_t)(R0 + i) * NIN + c]);
            AB[(size_t)(R0 + i) * DM + c] = (bf16_t)(pk2(u * y, 0.f) & 0xffffu); }
        const float* cw = ap->in[11] + (size_t)il * 3 * 512; const float w0 = cw[c], w1 = cw[512 + c], w2 = cw[1024 + c];
        const float* st = ap->in[2] + (size_t)(il * DB + db) * 2 * 512;
        float c0 = st[c], c1 = st[512 + c];
#pragma unroll
        for (int t = 0; t < 8; ++t) { const bf16_t* zr = Z + (size_t)(R0 + t) * NIN + c;
            const float c2 = bf2f(zr[1536]) * bf2f(zr[2048]);
            const float o = bf2f(zr[1024]) * (w0 * c0 + w1 * c1 + w2 * c2);
            AB[(size_t)(R0 + t) * DM + 512 + c] = (bf16_t)(pk2(o, 0.f) & 0xffffu);
            c0 = c1; c1 = c2; }
        float* cs = ap->out + O_CONVS + (size_t)(il * DB + db) * 2 * 512;
        cs[c] = c0; cs[512 + c] = c1;
    }
    __syncthreads();
}

__device__ __forceinline__ void att_prompt_tile(unsigned char* ws, LAS unsigned char* vt, int b, int g, int h, int r, int qt, int lane) {
    const bf16_t* QKV = (const bf16_t*)(ws + WS_BIG); bf16_t* OG = (bf16_t*)(ws + WS_OG); float* LSE = (float*)(ws + WS_LSE);
    const int d = 1 << (2 * g), ql = lane & 31, hi = lane >> 5, q0 = qt * 32, kb = q0 - 128;
    const bf16_t* base = QKV + (size_t)(b * SEQ + r) * NQKV + g * 512 + h * 64;
    const size_t ms = (size_t)d * NQKV;
    bf16x8 qf[4];
    { const bf16_t* qp = base + (size_t)(q0 + ql) * ms + hi * 8;
#pragma unroll
      for (int d0 = 0; d0 < 4; ++d0) qf[d0] = *(const bf16x8*)(qp + d0 * 16); }
    const int keyl = (ql & 0x13) | ((ql & 4) << 1) | ((ql & 8) >> 1);
    const float sc = 0.125f * LOG2E, sl = exp2f(-(float)(h + 1)) * (float)d * LOG2E;
    const int t0 = ql - 8 * hi;
    float m = -1e30f, l = 0.f;
    f32x16 O0 = {0.f, 0.f, 0.f, 0.f, 0.f, 0.f, 0.f, 0.f, 0.f, 0.f, 0.f, 0.f, 0.f, 0.f, 0.f, 0.f}, O1 = O0;
    const int sp = lane & 15, scn = lane >> 4;
    const int kt0 = kb < 0 ? ((-kb) >> 5) : 0;
    const bf16_t* kp = base + 1536 + (size_t)(kb + 32 * kt0 + keyl) * ms + hi * 8;
    const bf16_t* vp = base + 3072 + (size_t)(kb + 32 * kt0 + 2 * sp) * ms + scn * 8;
#pragma unroll 1
    for (int kt = kt0; kt < 5; ++kt, kp += 32 * ms, vp += 32 * ms) {
        bf16x8 kf[4];
#pragma unroll
        for (int d0 = 0; d0 < 4; ++d0) kf[d0] = *(const bf16x8*)(kp + d0 * 16);
        const u32x4 va0 = *(const u32x4*)(vp), va1 = *(const u32x4*)(vp + ms), vb0 = *(const u32x4*)(vp + 32), vb1 = *(const u32x4*)(vp + ms + 32);
        f32x16 S = {0.f, 0.f, 0.f, 0.f, 0.f, 0.f, 0.f, 0.f, 0.f, 0.f, 0.f, 0.f, 0.f, 0.f, 0.f, 0.f};
#pragma unroll
        for (int d0 = 0; d0 < 4; ++d0) S = __builtin_amdgcn_mfma_f32_32x32x16_bf16(kf[d0], qf[d0], S, 0, 0, 0);
        float tm = -1e30f;
#pragma unroll
        for (int rr = 0; rr < 16; ++rr) { const int crr = (rr & 7) + 16 * (rr >> 3), delta = 128 - 32 * kt + t0 - crr;
            float sv = S[rr] * sc - sl * (float)delta;
            sv = ((unsigned)delta <= 128u) ? sv : -1e30f; asm volatile("" : "+v"(sv));
            S[rr] = sv; tm = fmaxf(tm, sv); }
        tm = fmaxf(tm, __shfl_xor(tm, 32));
        const float mn = fmaxf(m, tm), corr = __builtin_amdgcn_exp2f(m - mn); m = mn;
        float ps = 0.f;
#pragma unroll
        for (int rr = 0; rr < 16; ++rr) { const float p = __builtin_amdgcn_exp2f(S[rr] - mn); ps += p; S[rr] = p; }
        l = l * corr + ps;
        O0 = O0 * corr; O1 = O1 * corr;
        bf16x8 pk[2];
#pragma unroll
        for (int j = 0; j < 2; ++j) { u32x4 w; w.x = pk2(S[8 * j + 0], S[8 * j + 1]); w.y = pk2(S[8 * j + 2], S[8 * j + 3]); w.z = pk2(S[8 * j + 4], S[8 * j + 5]); w.w = pk2(S[8 * j + 6], S[8 * j + 7]);
            pk[j] = __builtin_bit_cast(bf16x8, w); }
        WAVE_LDS_FENCE();
        { LAS unsigned char* wp = vt + ((scn * 8) * 40 + 2 * sp) * 2;
#define VT_ST(V0, V1, OFF) do { \
            *(LAS unsigned*)(wp + (OFF) + 0 * 80) = (V0.x & 0xffffu) | (V1.x << 16); *(LAS unsigned*)(wp + (OFF) + 1 * 80) = (V0.x >> 16) | (V1.x & 0xffff0000u); \
            *(LAS unsigned*)(wp + (OFF) + 2 * 80) = (V0.y & 0xffffu) | (V1.y << 16); *(LAS unsigned*)(wp + (OFF) + 3 * 80) = (V0.y >> 16) | (V1.y & 0xffff0000u); \
            *(LAS unsigned*)(wp + (OFF) + 4 * 80) = (V0.z & 0xffffu) | (V1.z << 16); *(LAS unsigned*)(wp + (OFF) + 5 * 80) = (V0.z >> 16) | (V1.z & 0xffff0000u); \
            *(LAS unsigned*)(wp + (OFF) + 6 * 80) = (V0.w & 0xffffu) | (V1.w << 16); *(LAS unsigned*)(wp + (OFF) + 7 * 80) = (V0.w >> 16) | (V1.w & 0xffff0000u); } while (0)
          VT_ST(va0, va1, 0); VT_ST(vb0, vb1, 32 * 80);
#undef VT_ST
        }
        WAVE_LDS_FENCE();
#pragma unroll
        for (int j = 0; j < 2; ++j) { const bf16x8 v0 = *(const LAS bf16x8*)(vt + (ql * 40 + 16 * j + 8 * hi) * 2), v1 = *(const LAS bf16x8*)(vt + ((32 + ql) * 40 + 16 * j + 8 * hi) * 2);
            O0 = __builtin_amdgcn_mfma_f32_32x32x16_bf16(v0, pk[j], O0, 0, 0, 0); O1 = __builtin_amdgcn_mfma_f32_32x32x16_bf16(v1, pk[j], O1, 0, 0, 0); }
    }
    l += __shfl_xor(l, 32);
    const float inv = 1.0f / l;
    const int row = b * SEQ + (q0 + ql) * d + r;
    bf16_t* op = OG + ((size_t)g * MROWS + row) * 512 + h * 64 + 4 * hi;
#pragma unroll
    for (int rr = 0; rr < 4; ++rr) { u32x2 w; w.x = pk2(O0[4 * rr] * inv, O0[4 * rr + 1] * inv); w.y = pk2(O0[4 * rr + 2] * inv, O0[4 * rr + 3] * inv); *(u32x2*)(op + 8 * rr) = w;
        u32x2 w2; w2.x = pk2(O1[4 * rr] * inv, O1[4 * rr + 1] * inv); w2.y = pk2(O1[4 * rr + 2] * inv, O1[4 * rr + 3] * inv); *(u32x2*)(op + 32 + 8 * rr) = w2; }
    if (hi == 0) LSE[((size_t)g * MROWS + row) * 8 + h] = m + __builtin_amdgcn_logf(l);
}

__device__ __forceinline__ void att_sample_query(ArgP ap, int il, int db, int g, int h, int t, int lane) {
    const bf16_t* QKV = (const bf16_t*)(ap->ws + WS_BIG); bf16_t* OG = (bf16_t*)(ap->ws + WS_OG); float* LSE = (float*)(ap->ws + WS_LSE);
    const int d = 1 << (2 * g), L = 128 << (2 * g), kg = lane >> 4, dl = lane & 15;
    const float* cache = ap->in[3 + g] + ((size_t)(il * DB + db) * L) * 1024 + h * 64 + 4 * dl;
    const int R = MP + db * 8 + t;
    const bf16_t* nrow = QKV + (size_t)(MP + db * 8) * NQKV + g * 512 + h * 64 + 4 * dl;
    float q[4];
    { const u32x2 w = *(const u32x2*)(nrow + (size_t)t * NQKV); q[0] = __uint_as_float(w.x << 16); q[1] = __uint_as_float(w.x & 0xffff0000u); q[2] = __uint_as_float(w.y << 16); q[3] = __uint_as_float(w.y & 0xffff0000u); }
    const float sc = 0.125f * LOG2E, sl = exp2f(-(float)(h + 1)) * (float)d * LOG2E;
    float m = -1e30f, l = 0.f, o[4] = {0.f, 0.f, 0.f, 0.f};
#define SQ_UPDATE(VALID, STEP) do { float dot = (q[0] * k[0] + q[1] * k[1]) + (q[2] * k[2] + q[3] * k[3]); \
        dot += __shfl_xor(dot, 1); dot += __shfl_xor(dot, 2); dot += __shfl_xor(dot, 4); dot += __shfl_xor(dot, 8); \
        const float s2 = (VALID) ? dot * sc - sl * (float)(STEP) : -1e30f; \
        const float mn = fmaxf(m, s2), corr = __builtin_amdgcn_exp2f(m - mn), p = (VALID) ? __builtin_amdgcn_exp2f(s2 - mn) : 0.f; \
        l = l * corr + p; _Pragma("unroll") for (int e = 0; e < 4; ++e) o[e] = o[e] * corr + p * v[e]; m = mn; } while (0)
    const int snew = t >> (2 * g);
    {
#pragma unroll
        for (int i = 0; i < 2; ++i) { const int s = kg + 4 * i; const bool valid = s <= snew; const int sv = valid ? s : 0;
            const bf16_t* p = nrow + (size_t)(t - sv * d) * NQKV;
            const u32x2 kw = *(const u32x2*)(p + 1536), vw = *(const u32x2*)(p + 3072);
            float k[4], v[4];
            k[0] = __uint_as_float(kw.x << 16); k[1] = __uint_as_float(kw.x & 0xffff0000u); k[2] = __uint_as_float(kw.y << 16); k[3] = __uint_as_float(kw.y & 0xffff0000u);
            v[0] = __uint_as_float(vw.x << 16); v[1] = __uint_as_float(vw.x & 0xffff0000u); v[2] = __uint_as_float(vw.y << 16); v[3] = __uint_as_float(vw.y & 0xffff0000u);
            SQ_UPDATE(valid, s); }
    }
    {
        const int s0 = snew + 1 + kg;
#pragma unroll 1
        for (int ib = 0; ib < 32; ib += 8) {
            f32x4 kk[8], vv[8];
#pragma unroll
            for (int i = 0; i < 8; ++i) { const int s = s0 + 4 * (ib + i), sv = s <= 128 ? s : 128; const float* cp = cache + (size_t)(L + t - sv * d) * 1024;
                kk[i] = *(const f32x4*)cp; vv[i] = *(const f32x4*)(cp + 512); }
#pragma unroll
            for (int i = 0; i < 8; ++i) { const int s = s0 + 4 * (ib + i); const bool valid = s <= 128;
                const float k[4] = {kk[i][0], kk[i][1], kk[i][2], kk[i][3]}, v[4] = {vv[i][0], vv[i][1], vv[i][2], vv[i][3]};
                SQ_UPDATE(valid, s); }
        }
    }
#undef SQ_UPDATE
    float M = fmaxf(m, __shfl_xor(m, 16)); M = fmaxf(M, __shfl_xor(M, 32));
    const float f = __builtin_amdgcn_exp2f(m - M);
    l *= f; l += __shfl_xor(l, 16); l += __shfl_xor(l, 32);
#pragma unroll
    for (int e = 0; e < 4; ++e) { o[e] *= f; o[e] += __shfl_xor(o[e], 16); o[e] += __shfl_xor(o[e], 32); }
    const float inv = 1.0f / l;
    if (kg == 0) { u32x2 w; w.x = pk2(o[0] * inv, o[1] * inv); w.y = pk2(o[2] * inv, o[3] * inv);
        *(u32x2*)(OG + ((size_t)g * MROWS + R) * 512 + h * 64 + 4 * dl) = w; }
    if (lane == 0) LSE[((size_t)g * MROWS + R) * 8 + h] = M + __builtin_amdgcn_logf(l);
}

__device__ __forceinline__ void att_phase(ArgP ap, LAS unsigned char* lds, int il, int gw, int NGW, int wave, int lane) {
    LAS unsigned char* vt = lds + wave * 5120;
    for (int sq = gw; sq < 3 * DB * 8 * 8; sq += NGW) { const int h = sq & 7, t = (sq >> 3) & 7, db = (sq >> 6) & 31, g = sq >> 11;
#ifndef SKIP_ATTS
        att_sample_query(ap, il, db, g, h, t, lane);
#endif
        }
    for (int wt = gw; wt < 2 * 3 * 8 * 256; wt += NGW) { const int idx = wt & 255, h = (wt >> 8) & 7, bg = wt >> 11, g = bg % 3, b = bg / 3;
        const int tpr = 256 >> (2 * g);
#ifndef SKIP_ATTP
        att_prompt_tile(ap->ws, vt, b, g, h, idx / tpr, idx % tpr, lane);
#endif
        }
}

__device__ __forceinline__ void merge_phase(ArgP ap, int il, int gt, int NGT) {
    const bf16_t* QKV = (const bf16_t*)(ap->ws + WS_BIG); const bf16_t* OG = (const bf16_t*)(ap->ws + WS_OG); const float* LSE = (const float*)(ap->ws + WS_LSE); bf16_t* O = (bf16_t*)(ap->ws + WS_AB);
    for (int u = gt; u < MROWS * 64; u += NGT) { const int row = u >> 6, c8 = u & 63, h = c8 >> 3;
        const float l0 = LSE[((size_t)0 * MROWS + row) * 8 + h], l1 = LSE[((size_t)1 * MROWS + row) * 8 + h], l2 = LSE[((size_t)2 * MROWS + row) * 8 + h];
        const float mx = fmaxf(l0, fmaxf(l1, l2));
        float w0 = __builtin_amdgcn_exp2f(l0 - mx), w1 = __builtin_amdgcn_exp2f(l1 - mx), w2 = __builtin_amdgcn_exp2f(l2 - mx);
        const float inv = 1.0f / (w0 + w1 + w2); w0 *= inv; w1 *= inv; w2 *= inv;
        float f0[8], f1[8], f2[8];
        unpack8(*(const u32x4*)(OG + ((size_t)0 * MROWS + row) * 512 + c8 * 8), f0); unpack8(*(const u32x4*)(OG + ((size_t)1 * MROWS + row) * 512 + c8 * 8), f1); unpack8(*(const u32x4*)(OG + ((size_t)2 * MROWS + row) * 512 + c8 * 8), f2);
        float o[8];
#pragma unroll
        for (int e = 0; e < 8; ++e) o[e] = w0 * f0[e] + w1 * f1[e] + w2 * f2[e];
        u32x4 w; w.x = pk2(o[0], o[1]); w.y = pk2(o[2], o[3]); w.z = pk2(o[4], o[5]); w.w = pk2(o[6], o[7]);
        *(u32x4*)(O + (size_t)row * 512 + c8 * 8) = w; }
#pragma unroll 1
    for (int g = 0; g < 3; ++g) { const int n = 128 << (2 * g); float* dst = ap->out + (g == 0 ? O_KVP0 : g == 1 ? O_KVP1 : O_KVP2) + (size_t)il * NB * n * 1024;
        for (int u = gt; u < NB * n * 128; u += NGT) { const int c8 = u & 63, kv = (u >> 6) & 1, rj = u >> 7, b = rj / n, j = rj - b * n;
            float f[8]; unpack8(*(const u32x4*)(QKV + (size_t)(b * SEQ + SEQ - n + j) * NQKV + (1 + kv) * 1536 + g * 512 + c8 * 8), f);
            float* p = dst + (size_t)rj * 1024 + kv * 512 + c8 * 8; *(f32x4*)p = (f32x4){f[0], f[1], f[2], f[3]}; *(f32x4*)(p + 4) = (f32x4){f[4], f[5], f[6], f[7]}; } }
#pragma unroll 1
    for (int g = 0; g < 3; ++g) { const int L = 128 << (2 * g); float* dst = ap->out + (g == 0 ? O_KVS0 : g == 1 ? O_KVS1 : O_KVS2) + (size_t)il * DB * L * 1024;
        for (int u = gt; u < DB * 8 * 128; u += NGT) { const int c8 = u & 63, kv = (u >> 6) & 1, t = (u >> 7) & 7, db = u >> 10;
            float f[8]; unpack8(*(const u32x4*)(QKV + (size_t)(MP + db * 8 + t) * NQKV + (1 + kv) * 1536 + g * 512 + c8 * 8), f);
            float* p = dst + ((size_t)db * L + L - 8 + t) * 1024 + kv * 512 + c8 * 8; *(f32x4*)p = (f32x4){f[0], f[1], f[2], f[3]}; *(f32x4*)(p + 4) = (f32x4){f[4], f[5], f[6], f[7]}; } }
}

#define XB_TMO      128
#define XB_XCNT(j)  (256  + 64 * (j))
#define XB_XSUB(j)  (1280 + 64 * (j))
#define XB_XGEN(j)  (2304 + 64 * (j))
#define XB_TOP      3328
#define XB_TOPGEN   3392
#define XCD_BAR_WORDS 3456
#define XB_SPIN_CAP (1u << 18)

__device__ __forceinline__ unsigned xb_ld(unsigned* p)              { return __hip_atomic_load(p, __ATOMIC_RELAXED, __HIP_MEMORY_SCOPE_AGENT); }
__device__ __forceinline__ unsigned xb_add(unsigned* p, unsigned v) { return __hip_atomic_fetch_add(p, v, __ATOMIC_RELAXED, __HIP_MEMORY_SCOPE_AGENT); }
__device__ __forceinline__ unsigned xb_xcc_id() { return (unsigned)__builtin_amdgcn_s_getreg((3 << 11) | 20) & 0xFu; }
#define XB_SPIN(cond, bar) do { unsigned _sp = 0; while (cond) { __builtin_amdgcn_s_sleep(1); \
    if ((++_sp & 255u) == 0u) { if (xb_ld(&(bar)[XB_TMO])) break; if (_sp > XB_SPIN_CAP) { atomicAdd(&(bar)[XB_TMO], 1u); break; } } } } while (0)

struct XcdBarrier {
    unsigned* bar; unsigned x;
    volatile LAS unsigned* st;
};

__device__ __forceinline__ XcdBarrier xcd_barrier_post(unsigned* bar, volatile LAS unsigned* st) {
    XcdBarrier b; b.bar = bar; b.x = xb_xcc_id(); b.st = st;
    if (threadIdx.x == 0) (void)xb_add(&bar[XB_XCNT(b.x)], 1u);
    return b;
}
__device__ __forceinline__ void xcd_barrier_complete(unsigned* bar, unsigned x, unsigned& nloc, unsigned& nx) {
    const unsigned G = gridDim.x * gridDim.y * gridDim.z;
    unsigned sum, cnt, mine, sp = 0u;
    for (;;) {
        sum = 0u; cnt = 0u; mine = 0u;
#pragma unroll
        for (unsigned j = 0; j < 16; ++j) { const unsigned c = xb_ld(&bar[XB_XCNT(j)]); sum += c; cnt += (c > 0u) ? 1u : 0u; mine = (j == x) ? c : mine; }
        if (sum == G) break;
        __builtin_amdgcn_s_sleep(1);
        if ((++sp & 255u) == 0u) { if (xb_ld(&bar[XB_TMO])) break; if (sp > XB_SPIN_CAP) { atomicAdd(&bar[XB_TMO], 1u); break; } }
    }
    nloc = mine > 0u ? mine : 1u; nx = cnt > 0u ? cnt : 1u;
}

__device__ __forceinline__ void xcd_barrier(const XcdBarrier& b) {
    asm volatile("s_waitcnt vmcnt(0)" ::: "memory");
    __syncthreads();
    if (threadIdx.x == 0) {
        unsigned* bar = b.bar;
        __builtin_amdgcn_s_waitcnt(0);
        unsigned nloc = b.st[0], nx = b.st[1];
        if (nloc == 0u) { xcd_barrier_complete(bar, b.x, nloc, nx); b.st[0] = nloc; b.st[1] = nx; }
        const unsigned old = xb_add(&bar[XB_XSUB(b.x)], 1u);
        const unsigned gen = old / nloc;
        if (old + 1u == (gen + 1u) * nloc) {
            __builtin_amdgcn_fence(__ATOMIC_RELEASE, "agent");
            asm volatile("s_waitcnt vmcnt(0)" ::: "memory");
            const unsigned og = xb_add(&bar[XB_TOP], 1u);
            const unsigned tg = og / nx;
            if (og + 1u == (tg + 1u) * nx) xb_add(&bar[XB_TOPGEN], 1u);
            else XB_SPIN(xb_ld(&bar[XB_TOPGEN]) == tg, bar);
            __builtin_amdgcn_fence(__ATOMIC_ACQUIRE, "agent");
            xb_add(&bar[XB_XGEN(b.x)], 1u);
            asm volatile("s_waitcnt vmcnt(0)" ::: "memory");
        } else {
            XB_SPIN(xb_ld(&bar[XB_XGEN(b.x)]) == gen, bar);
            __builtin_amdgcn_fence(__ATOMIC_ACQUIRE, "agent");
            asm volatile("s_waitcnt vmcnt(0)" ::: "memory");
        }
    }
    __syncthreads();
}

#define RUN_GEMM(EPI, Aptr, Btptr, N_, K_, Eobj) do { pg8::Gemm g_{(const bf16_t*)(Aptr), (const bf16_t*)(Btptr), MROWS, (N_), (K_)}; pg8::StaticOrder S_; S_.init(MROWS, (N_), (int)gridDim.x, (int)blockIdx.x, (K_)); \
    pg8::gemm_phase<EPI, pg8::StaticOrder, true, true>(L, g_, S_, Eobj); } while (0)

#define RUN_GEMM_MIX(EPI, Aptr, Btptr, K_, Eobj) do { pg8::Gemm g_{(const bf16_t*)(Aptr), (const bf16_t*)(Btptr), MROWS, DM, (K_)}; MixOrder S_; S_.init((int)gridDim.x, (int)blockIdx.x, (K_)); \
    pg8::gemm_phase<EPI, MixOrder, true, true>(L, g_, S_, Eobj); } while (0)

__global__ void __launch_bounds__(NTHR, 2) mk_fwd(Args a_unused) {
    extern __shared__ __attribute__((aligned(16))) unsigned char lds_raw[];
    cg::grid_group grid = cg::this_grid();
    LAS unsigned char* L = (LAS unsigned char*)lds_raw;
    if (threadIdx.x < 8) ((LAS unsigned*)(L + MISC_OFF))[threadIdx.x] = 0u;
    unsigned char* const a_ws_ctl = ((ArgP)__builtin_amdgcn_kernarg_segment_ptr())->ws + WS_CTL;
    __syncthreads();
    const int NGW = gridDim.x * NWAVES, NGT = gridDim.x * NTHR;
#define FRESH_ARGS ArgP ap = (ArgP)__builtin_amdgcn_kernarg_segment_ptr(); asm volatile("" : "+s"(ap)); unsigned char* ws = ap->ws; (void)ws;
#define FRESH_IDS FRESH_ARGS int tid_ = threadIdx.x; asm volatile("" : "+v"(tid_)); const int tid = tid_, lane = tid & 63, wave = __builtin_amdgcn_readfirstlane(tid >> 6); \
    const int gw = blockIdx.x * NWAVES + wave, gt = blockIdx.x * NTHR + tid; (void)gw; (void)gt; (void)lane;

#ifndef SKIP_PRO
    { FRESH_IDS prologue(ap, L, gw, NGW, wave, lane); }
#endif
    grid.sync();
    const XcdBarrier bar = xcd_barrier_post((unsigned*)(a_ws_ctl), (volatile LAS unsigned*)(L + MISC_OFF));
#ifdef DUP_PRO
    { FRESH_IDS prologue(ap, L, gw, NGW, wave, lane); }
    xcd_barrier(bar);
#endif
#ifdef DUP_SYNC
    for (int k = 0; k < 40; ++k) xcd_barrier(bar);
#endif

#pragma unroll 1
    for (int layer = 0; layer < 4; ++layer) {
        const int il = layer >> 1;
        if ((layer & 1) == 0) {
#ifndef SKIP_G1E
            { FRESH_ARGS EpiAct<1> E{(bf16_t*)(ws + WS_BIG), NIN}; RUN_GEMM(EpiAct<1>, ws + WS_XB, ws + WS_WIN(il), NIN, DM, E);
              if ((int)blockIdx.x >= 138) host_copy(ap, COPY_PRO + (layer >> 1) * (118 + 240 + 110 + 240) * HOST_CNT, (int)blockIdx.x - 138, 118, (int)threadIdx.x); }
#endif
            xcd_barrier(bar);
#ifndef SKIP_MIX
            { FRESH_IDS for (int it = blockIdx.x; it < 32 + 512; it += gridDim.x) {
                if (it < 32) mix_sample(ap, L, il, it, tid, wave, lane);
                else mix_prompt(ap, L, il, (it - 32) >> 2, (it - 32) & 3, tid, wave, lane);
            } }
#endif
            xcd_barrier(bar);
#ifdef DUP_MIX
            { FRESH_IDS for (int it = blockIdx.x; it < 32 + 512; it += gridDim.x) {
                if (it < 32) mix_sample(ap, L, il, it, tid, wave, lane);
                else mix_prompt(ap, L, il, (it - 32) >> 2, (it - 32) & 3, tid, wave, lane);
            } }
            xcd_barrier(bar);
#endif
        } else {
#ifndef SKIP_G1O
            { FRESH_ARGS EpiAct<0> E{(bf16_t*)(ws + WS_BIG), NQKV}; RUN_GEMM(EpiAct<0>, ws + WS_XB, ws + WS_WQKV(il), NQKV, DM, E);
              if ((int)blockIdx.x >= 146) host_copy(ap, COPY_PRO + ((layer >> 1) * (118 + 240 + 110 + 240) + 118 + 240) * HOST_CNT, (int)blockIdx.x - 146, 110, (int)threadIdx.x); }
#endif
            xcd_barrier(bar);
#ifndef SKIP_ATT
            { FRESH_IDS att_phase(ap, L, il, gw, NGW, wave, lane); }
#endif
            xcd_barrier(bar);
#ifdef DUP_ATT
            { FRESH_IDS att_phase(ap, L, il, gw, NGW, wave, lane); }
            xcd_barrier(bar);
#endif
#ifndef SKIP_MRG
            { FRESH_IDS merge_phase(ap, il, gt, NGT); }
#endif
            xcd_barrier(bar);
#ifdef DUP_MRG
            { FRESH_IDS merge_phase(ap, il, gt, NGT); }
            xcd_barrier(bar);
#endif
        }
#ifndef SKIP_G2
        { FRESH_ARGS EpiRes E{(float*)(ws + WS_XF), (float*)(ws + WS_PART)}; const bool ev = (layer & 1) == 0;
          RUN_GEMM_MIX(EpiRes, ws + WS_AB, ws + (ev ? WS_WOUT(il) : WS_WOC(il)), ev ? DM : CW, E); }
#endif
        xcd_barrier(bar);
        { FRESH_IDS ln_phase(ws, ap->in[15] + layer * DM, ap->in[16] + layer * DM, nullptr, (layer & 1) ? 2 : 4, gw, NGW, lane); }
        xcd_barrier(bar);
#ifndef SKIP_G3
        { FRESH_ARGS EpiAct<2> E{(bf16_t*)(ws + WS_BIG), DFF}; RUN_GEMM(EpiAct<2>, ws + WS_XB, ws + WS_WUP(layer), DFF, DM, E);
          if ((int)blockIdx.x >= 16) host_copy(ap, COPY_PRO + ((layer >> 1) * (118 + 240 + 110 + 240) + ((layer & 1) ? 118 + 240 + 110 : 118)) * HOST_CNT, (int)blockIdx.x - 16, 240, (int)threadIdx.x); }
#endif
        xcd_barrier(bar);
#ifndef SKIP_G4
        { FRESH_ARGS EpiRes E{(float*)(ws + WS_XF), (float*)(ws + WS_PART)}; RUN_GEMM_MIX(EpiRes, ws + WS_BIG, ws + WS_WDN(layer), DFF, E); }
#endif
        xcd_barrier(bar);
        { FRESH_IDS ln_phase(ws, ap->in[17] + layer * DM, ap->in[18] + layer * DM, layer == 3 ? ap->out + O_Y : nullptr, 16, gw, NGW, lane); }
        if (layer < 3) xcd_barrier(bar);
    }
}

extern "C" void kernel_launch(void* const* d_in, const int* in_sizes, int n_in, void* d_out, int out_size, void* d_ws, size_t ws_size, hipStream_t stream) {
    static int grid = 0;
    if (grid == 0) {
        if (n_in != 21 || (size_t)out_size != O_END || ws_size < WS_END) { fprintf(stderr, "kernel_launch: unexpected shapes n_in %d out %d ws %zu\n", n_in, out_size, ws_size); grid = -1; return; }
        int dev = 0, cus = 0, per_cu = 0;
        hipGetDevice(&dev); hipDeviceGetAttribute(&cus, hipDeviceAttributeMultiprocessorCount, dev);
        if (hipFuncSetAttribute((const void*)mk_fwd, hipFuncAttributeMaxDynamicSharedMemorySize, LDS_BYTES) != hipSuccess) fprintf(stderr, "kernel_launch: hipFuncSetAttribute failed\n");
        if (hipOccupancyMaxActiveBlocksPerMultiprocessor(&per_cu, (const void*)mk_fwd, NTHR, LDS_BYTES) != hipSuccess || per_cu < 1) { fprintf(stderr, "kernel_launch: occupancy query says %d\n", per_cu); per_cu = 1; }
        (void)hipGetLastError();
        grid = cus * per_cu;
        if (grid != 256) { fprintf(stderr, "kernel_launch: this kernel's static work split needs exactly 256 resident workgroups (got %d x %d)\n", cus, per_cu); grid = -1; return; }
    }
    if (grid < 0) return;
    if (hipMemsetAsync((char*)d_ws + WS_CTL, 0, 65536, stream) != hipSuccess) { fprintf(stderr, "kernel_launch: hipMemsetAsync failed\n"); return; }
    Args ha{};
    for (int i = 0; i < 21; ++i) ha.in[i] = (const float*)d_in[i];
    ha.out = (float*)d_out; ha.ws = (unsigned char*)d_ws;
    void* args[] = {&ha};
    hipError_t e = hipLaunchCooperativeKernel((const void*)mk_fwd, dim3(grid), dim3(NTHR), args, LDS_BYTES, stream);
    if (e != hipSuccess) fprintf(stderr, "kernel_launch: cooperative launch failed: %s (grid %d)\n", hipGetErrorString(e), grid);
}
```
